# Optimizing an MI355X kernel written in HIP

```python
import jax
import jax.numpy as jnp
from jax import lax
import numpy as np

D_MODEL = 1024
BATCH = 32
SEQ = 256
DEPTH = 4
DEC_BATCH = 2
DEC_SEQ = 2048
PAST_LEN = 512

GRID_W = 64
N_MIXERS = 4
D_FF = 2816
EPS = 1e-6
N_MLSTM = (DEPTH + 3) // N_MIXERS
N_FOURIER = (DEPTH + 2) // N_MIXERS
N_GMLP = (DEPTH + 1) // N_MIXERS
N_NA = DEPTH // N_MIXERS

MLSTM_HEADS = 4
MLSTM_DK = D_MODEL // MLSTM_HEADS
MLSTM_DV = D_MODEL // MLSTM_HEADS
MLSTM_CHUNK = 128

FOURIER_GROUPS = 4

GMLP_WIDTH = D_MODEL
GMLP_GROUPS = 4
GMLP_CHUNK = 128

NA_HEADS = 16
NA_HD = D_MODEL // NA_HEADS
NA_KH = 8
NA_KW = 16
NA_QCB = 16
NA_KCB = 32
ATTN_QBLOCK = 128

kernel_name = 'hybrid_flow_backbone_step'


def rmsnorm(x, g):
    xf = x.astype(jnp.float32)
    y = xf * lax.rsqrt(jnp.mean(xf * xf, axis=-1, keepdims=True) + EPS)
    return y.astype(x.dtype) * g


def adaln(cond, w, b):
    m = jax.nn.silu(cond) @ w + b
    return m.reshape(m.shape[0], 1, 9, D_MODEL)


def sub_input(x, g, mods, idx):
    shift = mods[:, :, 3 * idx]
    scale = mods[:, :, 3 * idx + 1]
    gate = mods[:, :, 3 * idx + 2]
    return rmsnorm(x, g) * (1 + scale) + shift, gate


def swiglu(h, w1, w3, w2):
    return (jax.nn.silu(h @ w1) * (h @ w3)) @ w2


def mlstm_scan(q, k, v, i_pre, logf, C0, n0, m0):
    B, S = q.shape[0], q.shape[1]
    nc = S // MLSTM_CHUNK

    def to_chunks(a):
        return jnp.moveaxis(a.reshape(B, nc, MLSTM_CHUNK, *a.shape[2:]), 1, 0)

    xs = (to_chunks(q), to_chunks(k), to_chunks(v), to_chunks(i_pre), to_chunks(logf))
    causal = jnp.tril(jnp.ones((MLSTM_CHUNK, MLSTM_CHUNK), bool))[None, :, :, None]

    def step(carry, inp):
        C, n, m = carry
        qc, kc, vc, ic, fc = inp
        b = jnp.cumsum(fc, axis=1)
        dmat = b[:, :, None, :] - b[:, None, :, :] + ic[:, None, :, :]
        dmat = jnp.where(causal, dmat, -jnp.inf)
        inter = b + m[:, None, :]
        m_t = jnp.maximum(inter, jnp.max(dmat, axis=2))
        a = jnp.exp(dmat - m_t[:, :, None, :]) * jnp.einsum('bthk,bshk->btsh', qc, kc)
        w_inter = jnp.exp(inter - m_t)
        num = jnp.einsum('btsh,bshv->bthv', a, vc) + w_inter[..., None] * jnp.einsum('bhkv,bthk->bthv', C, qc)
        den = jnp.sum(a, axis=2) + w_inter * jnp.einsum('bhk,bthk->bth', n, qc)
        h = num / jnp.maximum(jnp.abs(den), jnp.exp(-m_t))[..., None]
        b_last = b[:, -1, :]
        g_s = b_last[:, None, :] - b + ic
        m_new = jnp.maximum(b_last + m, jnp.max(g_s, axis=1))
        w_s = jnp.exp(g_s - m_new[:, None, :])
        decay = jnp.exp(b_last + m - m_new)
        C_new = decay[..., None, None] * C + jnp.einsum('bsh,bshk,bshv->bhkv', w_s, kc, vc)
        n_new = decay[..., None] * n + jnp.einsum('bsh,bshk->bhk', w_s, kc)
        return (C_new, n_new, m_new), h

    init = (C0.astype(jnp.float32), n0.astype(jnp.float32), m0.astype(jnp.float32))
    (C, n, m), hs = lax.scan(step, init, xs)
    h = jnp.moveaxis(hs, 0, 1).reshape(B, S, MLSTM_HEADS, MLSTM_DV)
    return h, C, n, m


def mlstm_mixer(h, w_qkv, w_if, b_if, w_og, head_g, w_out, C0, n0, m0):
    B, S, _ = h.shape
    qkv = h @ w_qkv
    q = qkv[..., :D_MODEL].reshape(B, S, MLSTM_HEADS, MLSTM_DK).astype(jnp.float32)
    k = qkv[..., D_MODEL:2 * D_MODEL].reshape(B, S, MLSTM_HEADS, MLSTM_DK).astype(jnp.float32) * (MLSTM_DK ** -0.5)
    v = qkv[..., 2 * D_MODEL:].reshape(B, S, MLSTM_HEADS, MLSTM_DV).astype(jnp.float32)
    hs, Cs, ns, ms = [], [], [], []
    for d in range(2):
        g = (h @ w_if[d] + b_if[d]).astype(jnp.float32)
        seq = (q, k, v, g[..., :MLSTM_HEADS], jax.nn.log_sigmoid(g[..., MLSTM_HEADS:]))
        if d == 1:
            seq = tuple(jnp.flip(a, axis=1) for a in seq)
        hd, C, n, m = mlstm_scan(*seq, C0[:, d], n0[:, d], m0[:, d])
        if d == 1:
            hd = jnp.flip(hd, axis=1)
        hs.append(hd)
        Cs.append(C)
        ns.append(n)
        ms.append(m)
    hsum = hs[0] + hs[1]
    hn = hsum * lax.rsqrt(jnp.mean(hsum * hsum, axis=-1, keepdims=True) + EPS)
    hn = hn.reshape(B, S, D_MODEL).astype(h.dtype) * head_g
    y = (jax.nn.sigmoid(h @ w_og) * hn) @ w_out
    return y, (jnp.stack(Cs, axis=1), jnp.stack(ns, axis=1), jnp.stack(ms, axis=1))


def fourier_mixer(h, w_out, b_out):
    B, S, _ = h.shape
    hg = h.astype(jnp.float32).reshape(B, S, FOURIER_GROUPS, D_MODEL // FOURIER_GROUPS)
    f = jnp.fft.fft2(hg, axes=(1, 3), norm='ortho').real
    return f.reshape(B, S, D_MODEL).astype(h.dtype) @ w_out + b_out


def gmlp_mixer(h, w_in, b_in, v_g, w_s, b_s, w_out):
    B, S, _ = h.shape
    z = jax.nn.gelu(h @ w_in + b_in)
    u, v = z[..., :GMLP_WIDTH], z[..., GMLP_WIDTH:]
    v = rmsnorm(v, v_g)
    vg = v.reshape(B, S // GMLP_CHUNK, GMLP_CHUNK, GMLP_GROUPS, GMLP_WIDTH // GMLP_GROUPS)
    sv = jnp.einsum('gts,bnsgc->bntgc', w_s, vg) + b_s.T[None, None, :, :, None]
    return (u * sv.reshape(B, S, GMLP_WIDTH)) @ w_out


def na_qkv(h, w_qkv):
    B, S, _ = h.shape
    qkv = (h @ w_qkv).reshape(B, S, 3, NA_HEADS, NA_HD)
    return qkv[:, :, 0], qkv[:, :, 1], qkv[:, :, 2]


def context_attention(q, k, v):
    B, S, H, hd = q.shape
    nb = S // ATTN_QBLOCK
    qb = jnp.moveaxis(q.reshape(B, nb, ATTN_QBLOCK, H, hd), 1, 0)

    def block(qblk):
        s = jnp.einsum('bqhd,bkhd->bhqk', qblk, k).astype(jnp.float32) * (hd ** -0.5)
        p = jax.nn.softmax(s, axis=-1).astype(v.dtype)
        return jnp.einsum('bhqk,bkhd->bqhd', p, v)

    o = lax.map(block, qb)
    return jnp.moveaxis(o, 0, 1).reshape(B, S, H * hd)


def na_tables(rows):
    kh = min(NA_KH, rows)
    r = np.arange(rows)
    row_start = np.clip(r - NA_KH // 2, 0, rows - kh)
    key_rows = row_start[:, None] + np.arange(kh)[None, :]
    dr_idx = key_rows - r[:, None] + (NA_KH - 1)
    n_cb = GRID_W // NA_QCB
    qcols = np.arange(n_cb)[:, None] * NA_QCB + np.arange(NA_QCB)[None, :]
    col_start = np.clip(np.arange(n_cb) * NA_QCB - NA_KW // 2, 0, GRID_W - NA_KCB)
    key_cols = col_start[:, None] + np.arange(NA_KCB)[None, :]
    q_start = np.clip(qcols - NA_KW // 2, 0, GRID_W - NA_KW)
    kc = key_cols[:, None, :]
    mask = (kc >= q_start[:, :, None]) & (kc < q_start[:, :, None] + NA_KW)
    dc_idx = np.clip(kc - qcols[:, :, None] + (NA_KW - 1), 0, 2 * NA_KW - 2)
    return kh, key_rows, dr_idx, key_cols, mask, dc_idx


def na_latent(q, k, v, k_ctx, v_ctx, rpb):
    B, N, H, hd = q.shape
    rows = N // GRID_W
    kh, key_rows, dr_idx, key_cols, mask, dc_idx = na_tables(rows)
    n_cb = GRID_W // NA_QCB
    qg = q.reshape(B, rows, n_cb, NA_QCB, H, hd)
    kg = k.reshape(B, rows, GRID_W, H, hd)
    vg = v.reshape(B, rows, GRID_W, H, hd)
    ri = key_rows[:, None, :, None]
    ci = key_cols[None, :, None, :]
    kb = kg[:, ri, ci]
    vb = vg[:, ri, ci]
    scale = hd ** -0.5
    bias = jnp.moveaxis(rpb[:, dr_idx[:, None, None, :, None], dc_idx[None, :, :, None, :]], 0, 3)
    s_win = jnp.einsum('brcqhd,brcyxhd->brcqhyx', qg, kb).astype(jnp.float32) * scale + bias.astype(jnp.float32)
    s_win = jnp.where(mask[None, None, :, :, None, None, :], s_win, -jnp.inf)
    s_ctx = jnp.einsum('brcqhd,bkhd->brcqhk', qg, k_ctx).astype(jnp.float32) * scale
    n_win = kh * NA_KCB
    logits = jnp.concatenate([s_win.reshape(*s_win.shape[:5], n_win), s_ctx], axis=-1)
    p = jax.nn.softmax(logits, axis=-1).astype(v.dtype)
    p_win = p[..., :n_win].reshape(s_win.shape)
    out = jnp.einsum('brcqhyx,brcyxhd->brcqhd', p_win, vb) + jnp.einsum('brcqhk,bkhd->brcqhd', p[..., n_win:], v_ctx)
    return out.reshape(B, N, H * hd)


def setup_inputs(seed: int = 0) -> dict:
    key = jax.random.key(seed)
    ks = iter(list(jax.random.split(key, 40)))
    D = D_MODEL

    def nrm(shape, s=1.0):
        return jax.random.normal(next(ks), shape, jnp.float32) * s

    base_if = jnp.concatenate([jnp.zeros((MLSTM_HEADS,), jnp.float32), jnp.linspace(3.0, 6.0, MLSTM_HEADS)])
    return {
        'x_prompt': nrm((BATCH, SEQ, D)),
        'x_sample': nrm((DEC_BATCH, DEC_SEQ, D)),
        'state_mlstm_C': nrm((DEC_BATCH, N_MLSTM, 2, MLSTM_HEADS, MLSTM_DK, MLSTM_DV), 0.02),
        'state_mlstm_n': nrm((DEC_BATCH, N_MLSTM, 2, MLSTM_HEADS, MLSTM_DK), 0.1),
        'state_mlstm_m': nrm((DEC_BATCH, N_MLSTM, 2, MLSTM_HEADS), 0.5),
        'cache_na_k': nrm((DEC_BATCH, N_NA, PAST_LEN, NA_HEADS, NA_HD)),
        'cache_na_v': nrm((DEC_BATCH, N_NA, PAST_LEN, NA_HEADS, NA_HD)),
        'c': nrm((DEC_BATCH, D)),
        'c_ctx': nrm((D,)),
        'w_ada': nrm((DEPTH, D, 9 * D), 0.5 * D ** -0.5),
        'b_ada': nrm((DEPTH, 9 * D), 0.01),
        'norm_g': 1.0 + nrm((DEPTH, 3, D), 0.05),
        'final_g': 1.0 + nrm((D,), 0.05),
        'ffn_w1': nrm((DEPTH, 2, D, D_FF), D ** -0.5),
        'ffn_w3': nrm((DEPTH, 2, D, D_FF), D ** -0.5),
        'ffn_w2': nrm((DEPTH, 2, D_FF, D), D_FF ** -0.5),
        'ml_w_qkv': nrm((N_MLSTM, D, 3 * D), D ** -0.5),
        'ml_w_if': nrm((N_MLSTM, 2, D, 2 * MLSTM_HEADS), 0.1 * D ** -0.5),
        'ml_b_if': base_if + nrm((N_MLSTM, 2, 2 * MLSTM_HEADS), 0.1),
        'ml_w_og': nrm((N_MLSTM, D, D), D ** -0.5),
        'ml_head_g': 1.0 + nrm((N_MLSTM, D), 0.05),
        'ml_w_out': nrm((N_MLSTM, D, D), D ** -0.5),
        'fn_w_out': nrm((N_FOURIER, D, D), D ** -0.5),
        'fn_b_out': nrm((N_FOURIER, D), 0.01),
        'gm_w_in': nrm((N_GMLP, D, 2 * GMLP_WIDTH), D ** -0.5),
        'gm_b_in': nrm((N_GMLP, 2 * GMLP_WIDTH), 0.01),
        'gm_v_g': 1.0 + nrm((N_GMLP, GMLP_WIDTH), 0.05),
        'gm_w_s': nrm((N_GMLP, GMLP_GROUPS, GMLP_CHUNK, GMLP_CHUNK), GMLP_CHUNK ** -0.5),
        'gm_b_s': 1.0 + nrm((N_GMLP, GMLP_GROUPS, GMLP_CHUNK), 0.1),
        'gm_w_out': nrm((N_GMLP, GMLP_WIDTH, D), GMLP_WIDTH ** -0.5),
        'na_w_qkv': nrm((N_NA, D, 3 * D), D ** -0.5),
        'na_w_out': nrm((N_NA, D, D), D ** -0.5),
        'na_rpb': nrm((N_NA, NA_HEADS, 2 * NA_KH - 1, 2 * NA_KW - 1), 0.5),
    }


def reference(x_prompt, x_sample, state_mlstm_C, state_mlstm_n, state_mlstm_m, cache_na_k, cache_na_v, c, c_ctx,
              w_ada, b_ada, norm_g, final_g, ffn_w1, ffn_w3, ffn_w2,
              ml_w_qkv, ml_w_if, ml_b_if, ml_w_og, ml_head_g, ml_w_out,
              fn_w_out, fn_b_out, gm_w_in, gm_b_in, gm_v_g, gm_w_s, gm_b_s, gm_w_out,
              na_w_qkv, na_w_out, na_rpb):
    def run_layer(x, mods, l, mixer):
        h, gate = sub_input(x, norm_g[l, 0], mods, 0)
        x = x + 0.5 * gate * swiglu(h, ffn_w1[l, 0], ffn_w3[l, 0], ffn_w2[l, 0])
        h, gate = sub_input(x, norm_g[l, 1], mods, 1)
        y, aux = mixer(h)
        x = x + gate * y
        h, gate = sub_input(x, norm_g[l, 2], mods, 2)
        x = x + 0.5 * gate * swiglu(h, ffn_w1[l, 1], ffn_w3[l, 1], ffn_w2[l, 1])
        return x, aux

    xp, xs = x_prompt, x_sample
    B = xp.shape[0]
    new_C, new_n, new_m, new_k, new_v = [], [], [], [], []
    for l in range(DEPTH):
        kind, j = l % N_MIXERS, l // N_MIXERS
        mods_p = adaln(c_ctx[None, :], w_ada[l], b_ada[l])
        mods_s = adaln(c, w_ada[l], b_ada[l])
        if kind == 0:
            ml = (ml_w_qkv[j], ml_w_if[j], ml_b_if[j], ml_w_og[j], ml_head_g[j], ml_w_out[j])
            zC = jnp.zeros((B, 2, MLSTM_HEADS, MLSTM_DK, MLSTM_DV), jnp.float32)
            zn = jnp.zeros((B, 2, MLSTM_HEADS, MLSTM_DK), jnp.float32)
            zm = jnp.zeros((B, 2, MLSTM_HEADS), jnp.float32)
            xp, st = run_layer(xp, mods_p, l, lambda h: mlstm_mixer(h, *ml, zC, zn, zm))
            xs, _ = run_layer(xs, mods_s, l, lambda h: mlstm_mixer(
                h, *ml, state_mlstm_C[:, j], state_mlstm_n[:, j], state_mlstm_m[:, j]))
            new_C.append(st[0])
            new_n.append(st[1])
            new_m.append(st[2])
        elif kind == 1:
            fmix = lambda h: (fourier_mixer(h, fn_w_out[j], fn_b_out[j]), None)
            xp, _ = run_layer(xp, mods_p, l, fmix)
            xs, _ = run_layer(xs, mods_s, l, fmix)
        elif kind == 2:
            gmix = lambda h: (gmlp_mixer(h, gm_w_in[j], gm_b_in[j], gm_v_g[j], gm_w_s[j], gm_b_s[j], gm_w_out[j]), None)
            xp, _ = run_layer(xp, mods_p, l, gmix)
            xs, _ = run_layer(xs, mods_s, l, gmix)
        else:
            def na_ctx(h):
                q, k, v = na_qkv(h, na_w_qkv[j])
                return context_attention(q, k, v) @ na_w_out[j], (k, v)

            def na_lat(h):
                q, k, v = na_qkv(h, na_w_qkv[j])
                o = na_latent(q, k, v, cache_na_k[:, j], cache_na_v[:, j], na_rpb[j])
                return o @ na_w_out[j], None

            xp, kv = run_layer(xp, mods_p, l, na_ctx)
            xs, _ = run_layer(xs, mods_s, l, na_lat)
            new_k.append(kv[0])
            new_v.append(kv[1])
    return (rmsnorm(xp, final_g), rmsnorm(xs, final_g), jnp.stack(new_C, axis=1), jnp.stack(new_n, axis=1),
            jnp.stack(new_m, axis=1), jnp.stack(new_k, axis=1), jnp.stack(new_v, axis=1))
```

```cpp
#include <hip/hip_runtime.h>
#include <hip/hip_cooperative_groups.h>
#include <cstdio>
#include <cstdint>
namespace cg = cooperative_groups;

#define DI __device__ __forceinline__
#define LAS __attribute__((address_space(3)))
typedef unsigned short bf16_t;
typedef short bf16x8 __attribute__((ext_vector_type(8)));
typedef float f32x4 __attribute__((ext_vector_type(4)));
typedef float f32x2 __attribute__((ext_vector_type(2)));
typedef unsigned u32x4 __attribute__((ext_vector_type(4)));
typedef unsigned u32x2 __attribute__((ext_vector_type(2)));
typedef __bf16 bf16x2_t __attribute__((ext_vector_type(2)));
#define GAS __attribute__((address_space(1)))
typedef const GAS char* gcp;
typedef GAS char* gwp;

#ifndef NSTEPS_RUN
#define NSTEPS_RUN 1000
#endif

constexpr int M_TOK = 12288, M_CTX = 8192, DM = 1024, DFF = 2816, LDG = 2816;
constexpr float EPSN = 1e-6f;
constexpr size_t O_C = 12582912, O_N = 29360128, O_M = 29425664, O_K = 29425920, O_V = 37814528;
constexpr size_t MiB = 1u << 20;
constexpr size_t WS_MODS = 1 * MiB, WS_IFG = 2 * MiB, WS_ABLK = 3 * MiB, WS_DS256 = 3 * MiB + 512 * 1024, WS_DC = 3 * MiB + 768 * 1024;
constexpr size_t WS_DS2048 = 4 * MiB, WS_KC = 20 * MiB, WS_VCT = 22 * MiB, WS_MLST = 24 * MiB, WS_W = 26 * MiB;
constexpr size_t W13_BYTES = (size_t)5632 * 1024 * 2, W2_BYTES = (size_t)1024 * LDG * 2, FFN_BYTES = W13_BYTES + W2_BYTES;
constexpr size_t WS_MLQ = WS_W + 8 * FFN_BYTES, WS_MLO = WS_MLQ + 8 * MiB, WS_FNO = WS_MLO + 2 * MiB, WS_GMI = WS_FNO + 2 * MiB,
                 WS_GMO = WS_GMI + 4 * MiB, WS_NAQ = WS_GMO + 2 * MiB, WS_NAO = WS_NAQ + 6 * MiB, WS_HB = WS_NAO + 2 * MiB;
constexpr size_t WS_SCR = WS_HB + 24 * MiB;
constexpr size_t SCR_Q = 0, SCR_K = 24 * MiB, SCR_KT = 48 * MiB, SCR_VT = 72 * MiB, SCR_OG = 96 * MiB, SCR_SNAP = 120 * MiB;
constexpr size_t SCR_HT = 0, SCR_Y = 24 * MiB, SCR_U = 0, SCR_V = 24 * MiB, SCR_VNT = 48 * MiB;
constexpr size_t WS_END = WS_SCR + 184 * MiB;
static_assert(WS_HB % 4096 == 0 && FFN_BYTES % 256 == 0, "ws map");
constexpr int MLST_STRIDE = 272;

constexpr int LDS_BYTES = 153600 + 64, LDS_BARW = 153600;

enum { OP_PRO = 0, OP_NORM, OP_NORMT, OP_FFNUP, OP_FFNDN, OP_MLQKV, OP_ML1, OP_ML2, OP_MIXOUT, OP_F1L, OP_F1C, OP_F2, OP_GIN, OP_GTR, OP_GSP, OP_NAQKV, OP_NAATT, OP_FINAL };
__constant__ unsigned char PROG[][3] = {
    {OP_PRO, 0, 1},
    {OP_NORM, 0, 1}, {OP_FFNUP, 0, 1}, {OP_FFNDN, 0, 1}, {OP_NORM, 1, 1}, {OP_MLQKV, 0, 1}, {OP_ML1, 0, 1}, {OP_ML2, 0, 1}, {OP_MIXOUT, 0, 1}, {OP_NORM, 2, 1}, {OP_FFNUP, 1, 1}, {OP_FFNDN, 1, 1},
    {OP_NORM, 4, 1}, {OP_FFNUP, 2, 1}, {OP_FFNDN, 2, 1}, {OP_NORMT, 5, 1}, {OP_F1L, 0, 0}, {OP_F1C, 0, 1}, {OP_F2, 0, 1}, {OP_MIXOUT, 1, 1}, {OP_NORM, 6, 1}, {OP_FFNUP, 3, 1}, {OP_FFNDN, 3, 1},
    {OP_NORM, 8, 1}, {OP_FFNUP, 4, 1}, {OP_FFNDN, 4, 1}, {OP_NORM, 9, 1}, {OP_GIN, 0, 1}, {OP_GTR, 0, 1}, {OP_GSP, 0, 1}, {OP_MIXOUT, 2, 1}, {OP_NORM, 10, 1}, {OP_FFNUP, 5, 1}, {OP_FFNDN, 5, 1},
    {OP_NORM, 12, 1}, {OP_FFNUP, 6, 1}, {OP_FFNDN, 6, 1}, {OP_NORM, 13, 1}, {OP_NAQKV, 0, 1}, {OP_NAATT, 0, 1}, {OP_MIXOUT, 3, 1}, {OP_NORM, 14, 1}, {OP_FFNUP, 7, 1}, {OP_FFNDN, 7, 1},
    {OP_FINAL, 0, 0}};
constexpr int NSTEPS = sizeof(PROG) / 3;
__constant__ int BGTAB[][4] = {
    {0,0,0,0},
    {0,0,0,0}, {4224,8448,0,0}, {8448,12672,0,0}, {0,0,0,0}, {0,0,0,0}, {0,0,0,0}, {0,0,0,0}, {0,0,0,0}, {0,0,0,0}, {12672,16896,33792+2560,33792+3072}, {16896,21120,0,0},
    {0,0,0,0}, {21120,25344,33792+3072,33792+4608}, {25344,29568,0,0}, {0,0,0,0}, {0,0,0,0}, {0,0,0,0}, {0,0,0,0}, {0,0,0,0}, {0,0,0,0}, {29568,33792,33792+4608,33792+6656}, {0,0,0,0},
    {0,0,0,0}, {0,0,0,0}, {0,0,0,0}, {0,0,0,0}, {0,0,0,0}, {0,0,0,0}, {0,0,0,0}, {0,0,0,0}, {0,0,0,0}, {0,0,0,0}, {0,0,0,0},
    {0,0,0,0}, {0,0,0,0}, {0,0,0,0}, {0,0,0,0}, {0,0,0,0}, {0,0,0,0}, {0,0,0,0}, {0,0,0,0}, {0,0,0,0}, {0,0,0,0},
    {0,0,0,0}};
static_assert(sizeof(BGTAB) / 16 == NSTEPS, "BGTAB rows");

struct Params { const float* in[33]; float* out; unsigned char* ws; };
typedef const __attribute__((address_space(4))) Params* KP;

DI unsigned pk2(float lo, float hi) { f32x2 v = {lo, hi}; bf16x2_t b = __builtin_convertvector(v, bf16x2_t); return __builtin_bit_cast(unsigned, b); }
DI float bflo(unsigned u) { return __uint_as_float(u << 16); }
DI float bfhi(unsigned u) { return __uint_as_float(u & 0xffff0000u); }
DI float bperm(int src_lane, float v) { return __int_as_float(__builtin_amdgcn_ds_bpermute(src_lane << 2, __float_as_int(v))); }
DI float shx(float v, int mask, int lane) { return bperm(lane ^ mask, v); }
DI float wave_sum(float v, int lane) {
#pragma unroll
    for (int o = 1; o < 64; o <<= 1) v += shx(v, o, lane);
    return v;
}
DI float wave_max(float v, int lane) {
#pragma unroll
    for (int o = 1; o < 64; o <<= 1) v = fmaxf(v, shx(v, o, lane));
    return v;
}
DI float fsigmoid(float x) { return __builtin_amdgcn_rcpf(1.0f + __expf(-x)); }
DI float fsilu(float x) { return x * fsigmoid(x); }
DI float fgelu_tanh(float x) { const float u = 1.5957691216f * (x + 0.044715f * x * x * x); return x * fsigmoid(u); }
DI float logsigmoidf(float x) { return fminf(x, 0.f) - __logf(1.0f + __expf(-fabsf(x))); }
DI bf16x8 ldf16(const void* ub, unsigned vo) { return *(const bf16x8*)((const char*)ub + vo); }
DI u32x2 ldf8(const void* ub, unsigned vo) { return *(const u32x2*)((const char*)ub + vo); }
#define MFMA16(a, b, c) __builtin_amdgcn_mfma_f32_16x16x32_bf16((a), (b), (c), 0, 0, 0)

DI int fresh_lane() { int z = 0; asm volatile("" : "+v"(z)); return (int)__builtin_amdgcn_mbcnt_hi(~0u, __builtin_amdgcn_mbcnt_lo(~0u, z)); }
namespace pg8 {
constexpr int BM = 256, BK = 64, HALF = 128, HTB = HALF * BK * 2, STAGE_BYTES = 8 * HTB;
DI int lds_byte(int r, int c) { const int st = (r >> 4) * 2 + (c >> 5), rr = r & 15, cc = c & 31, ob = rr * 64 + cc * 2; return st * 1024 + (ob ^ (((ob >> 9) & 1) << 5)); }
DI void stage_rc(int b, int& R, int& C) { const int st = b / 1024, sb = b % 1024, swz = sb ^ (((sb >> 9) & 1) << 5); R = (st >> 1) * 16 + swz / 64; C = (st & 1) * 32 + (swz % 64) / 2; }
DI int perm32(int rho) { const int n = rho >> 4, i = rho & 15; return 8 * (i >> 2) + 4 * n + (i & 3); }

struct Unit { const char* A; const char* B; int pm, pn, z; };
enum { E_FFNUP = 0, E_RES, E_MLQKV, E_NAQKV, E_F1, E_F2, E_GIN, E_SP };
struct GD {
    const char* A; const char* B; int lda, ldb, K, nM, nN, nZ; long sAz, sBz, sApn; int perm, mode;
    int G, c;
    unsigned char* ws; float* out; const float* p0; const float* p1; const float* p2; const float* p3; float f0; int i0, i1;
};
DI bool gd_next(const GD& g, int i, Unit& u) {
    const long L = (long)i * g.G + g.c; const int nwg = g.nZ * g.nM * g.nN; if (L >= nwg) return false;
    int wgid = (int)L; { const int q = nwg / 8, r = nwg % 8, xcd = wgid % 8, off = wgid / 8; wgid = (xcd < r ? xcd * (q + 1) : r * (q + 1) + (xcd - r) * q) + off; }
    const int per = g.nM * g.nN, z = wgid / per, w = wgid - z * per;
    const int nig = 6 * g.nN, gid = w / nig, fm = gid * 6, gsz = (g.nM - fm) < 6 ? (g.nM - fm) : 6;
    u.pm = fm + ((w % nig) % gsz); u.pn = (w % nig) / gsz; u.z = z;
    u.A = g.A + (long)z * g.sAz + (long)u.pm * 256 * g.lda * 2 + (long)u.pn * g.sApn;
    u.B = g.B + (long)z * g.sBz + (long)u.pn * 256 * g.ldb * 2;
    return true;
}

DI void store_T8(bf16_t* T, int c0, int row, int fr, const f32x4& v0, const f32x4& v1) {
    const unsigned o0 = pk2(v0[0], v0[1]), o1 = pk2(v0[2], v0[3]), o2 = pk2(v1[0], v1[1]), o3 = pk2(v1[2], v1[3]);
    const bool odd = fr & 1;
    const unsigned s0 = odd ? o0 : o2, s1 = odd ? o1 : o3;
    const unsigned r0 = (unsigned)__builtin_amdgcn_mov_dpp((int)s0, 0xB1, 0xF, 0xF, true), r1 = (unsigned)__builtin_amdgcn_mov_dpp((int)s1, 0xB1, 0xF, 0xF, true);
    const unsigned A0 = odd ? r0 : o0, A1 = odd ? r1 : o1, B0 = odd ? o2 : r0, B1 = odd ? o3 : r1;
    unsigned* d = (unsigned*)(T + (size_t)(c0 + (odd ? 4 : 0)) * M_TOK + (row & ~1));
    d[0] = (A0 & 0xffffu) | (B0 << 16); d[M_TOK / 2] = (A0 >> 16) | (B0 & 0xffff0000u); d[M_TOK] = (A1 & 0xffffu) | (B1 << 16); d[3 * (M_TOK / 2)] = (A1 >> 16) | (B1 & 0xffff0000u);
}
DI void epilogue(const GD& g, const f32x4 (&acc)[2][2][4][2], const Unit& u, int wr, int wc, int fr, int fq) {
    asm volatile("" : "+v"(fr), "+v"(fq));
    unsigned char* ws = g.ws;
    const int rowb = u.pm * 256 + wr * 64 + fr;
    if (g.mode == E_FFNUP) {
        bf16_t* G = (bf16_t*)(ws + WS_SCR);
        const int oc = (u.pn * 8 + (fq & 1) * 4 + wc) * 16 + (fq >> 1) * 8;
#pragma unroll
        for (int ai = 0; ai < 2; ++ai)
#pragma unroll
            for (int m = 0; m < 4; ++m) { const int row = rowb + ai * 128 + m * 16;
                const f32x4 a0 = acc[ai][0][m][0], b0 = acc[ai][0][m][1], a1 = acc[ai][1][m][0], b1 = acc[ai][1][m][1];
                unsigned A0 = pk2(fsilu(a0[0]) * b0[0], fsilu(a0[1]) * b0[1]), A1 = pk2(fsilu(a0[2]) * b0[2], fsilu(a0[3]) * b0[3]);
                unsigned B0 = pk2(fsilu(a1[0]) * b1[0], fsilu(a1[1]) * b1[1]), B1 = pk2(fsilu(a1[2]) * b1[2], fsilu(a1[3]) * b1[3]);
                { auto r0 = __builtin_amdgcn_permlane16_swap(A0, B0, false, false); A0 = r0[0]; B0 = r0[1]; auto r1 = __builtin_amdgcn_permlane16_swap(A1, B1, false, false); A1 = r1[0]; B1 = r1[1]; }
                u32x4 w; w.x = A0; w.y = A1; w.z = B0; w.w = B1;
                *(u32x4*)(G + (size_t)row * LDG + oc) = w; }
    } else if (g.mode == E_RES) {
        const int row0 = u.pm * 256; const int cond = row0 < M_CTX ? 0 : 1 + ((row0 - M_CTX) >> 11);
        const float* gate = g.p0 + cond * 9216; float* X = g.out; const float* Xr = g.p2 ? (row0 < M_CTX ? g.p2 : g.p3) : (const float*)g.out;
        f32x4 xv[2][4], gq[2], bq[2];
#define RES_COL(q) (u.pn * 256 + ((q) >> 1) * 128 + wc * 32 + 16 * ((q) & 1) + 4 * fq)
#define RES_GB(q) do { const int col_ = RES_COL(q); gq[(q) & 1] = *(const f32x4*)(gate + col_) * g.f0; bq[(q) & 1] = g.p1 ? *(const f32x4*)(g.p1 + col_) : (f32x4){0.f, 0.f, 0.f, 0.f}; } while (0)
#define RES_LOAD(t) do { const int col_ = RES_COL((t) >> 1); \
        _Pragma("unroll") for (int i_ = 0; i_ < 4; ++i_) xv[(t) & 1][i_] = *(const f32x4*)(Xr + (size_t)(rowb + ((t) & 1) * 128 + i_ * 16) * DM + col_); } while (0)
        RES_GB(0); RES_LOAD(0);
#pragma unroll
        for (int t = 0; t < 8; ++t) { const int q = t >> 1, ai = t & 1;
            if (t < 7) { if (((t + 1) & 1) == 0) RES_GB((t + 1) >> 1); RES_LOAD(t + 1); }
            const int col = RES_COL(q);
#pragma unroll
            for (int i = 0; i < 4; ++i) { const f32x4 r = xv[t & 1][i] + gq[q & 1] * (acc[ai][q >> 1][i][q & 1] + bq[q & 1]); *(f32x4*)(X + (size_t)(rowb + ai * 128 + i * 16) * DM + col) = r; } }
#undef RES_GB
#undef RES_COL
#undef RES_LOAD
    } else if (g.mode == E_MLQKV || g.mode == E_NAQKV) {
        const bool na = g.mode == E_NAQKV; const int sect = u.pn >> 2;
        bf16_t* Q = (bf16_t*)(ws + WS_SCR + SCR_Q); bf16_t* Kn = (bf16_t*)(ws + WS_SCR + SCR_K); bf16_t* KT = (bf16_t*)(ws + WS_SCR + SCR_KT);
        bf16_t* VT = (bf16_t*)(ws + WS_SCR + SCR_VT); bf16_t* OG = (bf16_t*)(ws + WS_SCR + SCR_OG);
#pragma unroll
        for (int ai = 0; ai < 2; ++ai)
#pragma unroll
            for (int m = 0; m < 4; ++m) { const int row = rowb + ai * 128 + m * 16;
#pragma unroll
                for (int bj = 0; bj < 2; ++bj) { const int c0 = (u.pn & 3) * 256 + bj * 128 + wc * 32 + 8 * fq; f32x4 v0 = acc[ai][bj][m][0], v1 = acc[ai][bj][m][1];
                    if (sect == 0) { const float s = na ? 0.125f : 1.0f; v0 *= s; v1 *= s; u32x4 w; w.x = pk2(v0[0], v0[1]); w.y = pk2(v0[2], v0[3]); w.z = pk2(v1[0], v1[1]); w.w = pk2(v1[2], v1[3]); *(u32x4*)(Q + (size_t)row * DM + c0) = w; }
                    else if (sect == 1) {
                        if (na) { if (row < M_CTX) { float* o = g.out + O_K + (size_t)row * DM + c0; __builtin_nontemporal_store(v0, (f32x4*)o); __builtin_nontemporal_store(v1, (f32x4*)(o + 4)); } }
                        else { v0 *= 0.0625f; v1 *= 0.0625f; }
                        u32x4 w; w.x = pk2(v0[0], v0[1]); w.y = pk2(v0[2], v0[3]); w.z = pk2(v1[0], v1[1]); w.w = pk2(v1[2], v1[3]); *(u32x4*)(Kn + (size_t)row * DM + c0) = w;
                        if (!na) store_T8(KT, c0, row, fr, v0, v1);
                    } else if (sect == 2) {
                        if (na && row < M_CTX) { float* o = g.out + O_V + (size_t)row * DM + c0; __builtin_nontemporal_store(v0, (f32x4*)o); __builtin_nontemporal_store(v1, (f32x4*)(o + 4)); }
                        store_T8(VT, c0, row, fr, v0, v1);
                    } else { u32x4 w; w.x = pk2(fsigmoid(v0[0]), fsigmoid(v0[1])); w.y = pk2(fsigmoid(v0[2]), fsigmoid(v0[3])); w.z = pk2(fsigmoid(v1[0]), fsigmoid(v1[1])); w.w = pk2(fsigmoid(v1[2]), fsigmoid(v1[3])); *(u32x4*)(OG + (size_t)row * DM + c0) = w; }
                } }
    } else if (g.mode == E_F1) {
        bf16_t* Y = (bf16_t*)(ws + WS_SCR + SCR_Y); const int S = g.i0, tok0 = g.i1 + u.z * S;
#pragma unroll
        for (int ai = 0; ai < 2; ++ai)
#pragma unroll
            for (int m = 0; m < 4; ++m) { const int r = rowb + ai * 128 + m * 16; const int cs = r >= S ? 1 : 0, sp = r - cs * S;
#pragma unroll
                for (int bj = 0; bj < 2; ++bj) { const int col = u.pn * 256 + bj * 128 + wc * 32 + 8 * fq, gi = col >> 8, c = col & 255; const f32x4 v0 = acc[ai][bj][m][0], v1 = acc[ai][bj][m][1];
                    u32x4 w; w.x = pk2(v0[0], v0[1]); w.y = pk2(v0[2], v0[3]); w.z = pk2(v1[0], v1[1]); w.w = pk2(v1[2], v1[3]);
                    *(u32x4*)(Y + ((size_t)(tok0 + sp) * 4 + gi) * 512 + cs * 256 + c) = w; } }
    } else if (g.mode == E_F2) {
        bf16_t* HB = (bf16_t*)(ws + WS_HB);
        const float sc = (u.pm * 64 < M_CTX) ? (1.0f / 256.0f) : 0.0013810679f;
#pragma unroll
        for (int ai = 0; ai < 2; ++ai)
#pragma unroll
            for (int m = 0; m < 4; ++m) { const int row = rowb + ai * 128 + m * 16;
#pragma unroll
                for (int bj = 0; bj < 2; ++bj) { const int col = bj * 128 + wc * 32 + 8 * fq; const f32x4 v0 = acc[ai][bj][m][0] * sc, v1 = acc[ai][bj][m][1] * sc;
                    u32x4 w; w.x = pk2(v0[0], v0[1]); w.y = pk2(v0[2], v0[3]); w.z = pk2(v1[0], v1[1]); w.w = pk2(v1[2], v1[3]);
                    *(u32x4*)(HB + (size_t)row * 256 + col) = w; } }
    } else if (g.mode == E_GIN) {
        bf16_t* U = (bf16_t*)(ws + WS_SCR + SCR_U); bf16_t* V = (bf16_t*)(ws + WS_SCR + SCR_V);
#pragma unroll
        for (int bj = 0; bj < 2; ++bj) { const int col = u.pn * 256 + bj * 128 + wc * 32 + 8 * fq; const f32x4 b0 = *(const f32x4*)(g.p0 + col), b1 = *(const f32x4*)(g.p0 + col + 4);
            bf16_t* dst = col < 1024 ? U + col : V + (col - 1024);
#pragma unroll
            for (int ai = 0; ai < 2; ++ai)
#pragma unroll
                for (int m = 0; m < 4; ++m) { const int row = rowb + ai * 128 + m * 16; const f32x4 v0 = acc[ai][bj][m][0] + b0, v1 = acc[ai][bj][m][1] + b1;
                    u32x4 w; w.x = pk2(fgelu_tanh(v0[0]), fgelu_tanh(v0[1])); w.y = pk2(fgelu_tanh(v0[2]), fgelu_tanh(v0[3])); w.z = pk2(fgelu_tanh(v1[0]), fgelu_tanh(v1[1])); w.w = pk2(fgelu_tanh(v1[2]), fgelu_tanh(v1[3]));
                    *(u32x4*)(dst + (size_t)row * DM) = w; } }
    } else {
        bf16_t* HB = (bf16_t*)(ws + WS_HB); const bf16_t* U = (const bf16_t*)(ws + WS_SCR + SCR_U);
        const int rb = u.z * 256 + wr * 64 + fr;
#pragma unroll
        for (int bj = 0; bj < 2; ++bj) { const int col = u.pn * 256 + bj * 128 + wc * 32 + 8 * fq; const f32x4 g0 = *(const f32x4*)(g.p0 + col), g1 = *(const f32x4*)(g.p0 + col + 4);
            u32x4 uv[2][4];
#pragma unroll
            for (int ai = 0; ai < 2; ++ai)
#pragma unroll
                for (int m = 0; m < 4; ++m) uv[ai][m] = *(const u32x4*)(U + (size_t)(rb + ai * 128 + m * 16) * DM + col);
            asm volatile("" ::: "memory");
#pragma unroll
            for (int ai = 0; ai < 2; ++ai)
#pragma unroll
                for (int m = 0; m < 4; ++m) { const int row = rb + ai * 128 + m * 16; const float bs = g.p1[u.pn * 128 + (row & 127)];
                    const u32x4 uu = uv[ai][m]; const f32x4 a0 = acc[ai][bj][m][0] * g0 + bs, a1 = acc[ai][bj][m][1] * g1 + bs;
                    u32x4 w; w.x = pk2(bflo(uu.x) * a0[0], bfhi(uu.x) * a0[1]); w.y = pk2(bflo(uu.y) * a0[2], bfhi(uu.y) * a0[3]); w.z = pk2(bflo(uu.z) * a1[0], bfhi(uu.z) * a1[1]); w.w = pk2(bflo(uu.w) * a1[2], bfhi(uu.w) * a1[3]);
                    *(u32x4*)(HB + (size_t)row * DM + col) = w; } }
    }
}

DI void gemm_phase(LAS unsigned char* lds, const GD& g, int wave_) {
    const int tid_ = wave_ * 64 + fresh_lane();
    const int tid = tid_, wid = __builtin_amdgcn_readfirstlane(tid >> 6), lane = tid & 63, wr = wid >> 2, wc = wid & 3, fr = lane & 15, fq = lane >> 4;
    const int K = g.K, nt = K / BK;
    unsigned voffA[2], voffB[2];
#pragma unroll
    for (int i = 0; i < 2; ++i) { int R, C; stage_rc(tid * 16 + i * 8192, R, C); const int Rb = g.perm ? ((R & ~31) + perm32(R & 31)) : R;
        voffA[i] = (unsigned)(R * g.lda + C) * 2u; voffB[i] = (unsigned)(Rb * g.ldb + C) * 2u; }
    const size_t kstep = (size_t)(BK * 2);
    const size_t hstepA = (size_t)HALF * g.lda * 2, hstepB = (size_t)HALF * g.ldb * 2;
    const unsigned ldsw = (unsigned)wid * 1024u;
    const int aoff = lds_byte(wr * 64 + fr, fq * 8), boff = lds_byte(wc * 32 + fr, fq * 8);
#define PG8_SA(b, h) (((b) * 2 + (h)) * HTB)
#define PG8_SB(b, h) ((4 + (b) * 2 + (h)) * HTB)
#define PG8_STAGE(bufoff, gbase, voff) do { _Pragma("unroll") for (int _i = 0; _i < 2; ++_i) \
        __builtin_amdgcn_global_load_lds((const unsigned*)((const char*)(gbase) + (voff)[_i]), (LAS unsigned*)(lds + (bufoff) + ldsw + _i * 8192), 16, 0, 0); } while (0)
#define PG8_LDA(dst, b, h) do { _Pragma("unroll") for (int m = 0; m < 4; ++m) _Pragma("unroll") for (int k = 0; k < 2; ++k) dst[m][k] = *(const LAS bf16x8*)(lds + PG8_SA(b, h) + aoff + m * 2048 + k * 1024); } while (0)
#define PG8_LDB(dst, b, h) do { _Pragma("unroll") for (int n = 0; n < 2; ++n) _Pragma("unroll") for (int k = 0; k < 2; ++k) dst[n][k] = *(const LAS bf16x8*)(lds + PG8_SB(b, h) + boff + n * 2048 + k * 1024); } while (0)
#define PG8_MMA(ai, bj, At, Bt) do { __builtin_amdgcn_s_setprio(1); _Pragma("unroll") for (int m = 0; m < 4; ++m) _Pragma("unroll") for (int n = 0; n < 2; ++n) _Pragma("unroll") for (int k = 0; k < 2; ++k) \
        acc[ai][bj][m][n] = __builtin_amdgcn_mfma_f32_16x16x32_bf16(Bt[n][k], At[m][k], acc[ai][bj][m][n], 0, 0, 0); __builtin_amdgcn_s_setprio(0); } while (0)
#define PG8_WAIT_V(n) asm volatile("s_waitcnt vmcnt(" #n ")" ::: "memory")
#define PG8_WAIT_L(n) asm volatile("s_waitcnt lgkmcnt(" #n ")" ::: "memory")
#define PG8_BAR __builtin_amdgcn_s_barrier()
#define PG8_SCHED __builtin_amdgcn_sched_barrier(0)
    Unit cur, nxt; int ui = 0;
    if (!gd_next(g, 0, cur)) return;
    f32x4 acc[2][2][4][2];
#pragma unroll
    for (int a = 0; a < 2; ++a)
#pragma unroll
        for (int b = 0; b < 2; ++b)
#pragma unroll
            for (int m = 0; m < 4; ++m)
#pragma unroll
                for (int n = 0; n < 2; ++n) acc[a][b][m][n] = (f32x4){0.f, 0.f, 0.f, 0.f};
    bf16x8 At[4][2], B0[2][2], B1[2][2];
    const char* cA = cur.A; const char* cB = cur.B;
    PG8_STAGE(PG8_SB(0, 0), cB, voffB); PG8_STAGE(PG8_SB(0, 1), cB + hstepB, voffB); PG8_STAGE(PG8_SA(0, 0), cA, voffA); PG8_STAGE(PG8_SA(0, 1), cA + hstepA, voffA);
    if (wr == 1) PG8_BAR;
    PG8_WAIT_V(2); PG8_BAR;
    PG8_STAGE(PG8_SB(1, 0), cB + kstep, voffB); PG8_STAGE(PG8_SA(1, 0), cA + kstep, voffA); PG8_STAGE(PG8_SB(1, 1), cB + hstepB + kstep, voffB);
    PG8_WAIT_V(6); PG8_BAR;
    for (;;) {
        const bool has_next = gd_next(g, ui + 1, nxt);
        const char* nA = has_next ? nxt.A : cA; const char* nB = has_next ? nxt.B : cB;
        for (int t = 0; t < nt; t += 2) {
            const bool last = (t == nt - 2);
            const char* a1 = cA + (size_t)(t + 1) * kstep;
            const char* a2 = last ? nA : cA + (size_t)(t + 2) * kstep; const char* b2 = last ? nB : cB + (size_t)(t + 2) * kstep;
            const char* a3 = a2 + kstep; const char* b3 = b2 + kstep;
            PG8_LDB(B0, 0, 0); PG8_LDB(B1, 0, 1); PG8_SCHED; PG8_LDA(At, 0, 0); PG8_STAGE(PG8_SA(1, 1), a1 + hstepA, voffA);
            PG8_WAIT_V(8); PG8_WAIT_L(0); PG8_BAR; PG8_MMA(0, 0, At, B0); PG8_MMA(0, 1, At, B1); PG8_BAR; PG8_SCHED;
            PG8_LDA(At, 0, 1); PG8_STAGE(PG8_SB(0, 0), b2, voffB); PG8_STAGE(PG8_SB(0, 1), b2 + hstepB, voffB); PG8_STAGE(PG8_SA(0, 0), a2, voffA);
            PG8_WAIT_V(8); PG8_WAIT_L(0); PG8_BAR; PG8_MMA(1, 0, At, B0); PG8_MMA(1, 1, At, B1); PG8_BAR; PG8_SCHED;
            PG8_LDB(B0, 1, 0); PG8_LDB(B1, 1, 1); PG8_SCHED; PG8_LDA(At, 1, 0); PG8_STAGE(PG8_SA(0, 1), a2 + hstepA, voffA);
            PG8_WAIT_V(8); PG8_WAIT_L(0); PG8_BAR; PG8_MMA(0, 0, At, B0); PG8_MMA(0, 1, At, B1); PG8_BAR; PG8_SCHED;
            PG8_LDA(At, 1, 1); PG8_STAGE(PG8_SB(1, 0), b3, voffB); PG8_STAGE(PG8_SB(1, 1), b3 + hstepB, voffB); PG8_STAGE(PG8_SA(1, 0), a3, voffA);
            PG8_WAIT_V(8); PG8_WAIT_L(0); PG8_BAR; PG8_MMA(1, 0, At, B0); PG8_MMA(1, 1, At, B1); PG8_BAR; PG8_SCHED;
        }
        if (wr == 0) PG8_BAR;
        epilogue(g, acc, cur, wr, wc, fr, fq);
        if (!has_next) break;
#pragma unroll
        for (int a = 0; a < 2; ++a)
#pragma unroll
            for (int b = 0; b < 2; ++b)
#pragma unroll
                for (int m = 0; m < 4; ++m)
#pragma unroll
                    for (int n = 0; n < 2; ++n) acc[a][b][m][n] = (f32x4){0.f, 0.f, 0.f, 0.f};
        cur = nxt; cA = nA; cB = nB; ++ui;
        if (wr == 1) PG8_BAR;
    }
    PG8_WAIT_V(0);
    PG8_BAR;
#undef PG8_SA
#undef PG8_SB
#undef PG8_STAGE
#undef PG8_LDA
#undef PG8_LDB
#undef PG8_MMA
#undef PG8_WAIT_V
#undef PG8_WAIT_L
#undef PG8_BAR
#undef PG8_SCHED
}
}

DI void tr_item(const float* W, int K, int N, bf16_t* WT, int mode, LAS float* scr, int item, int lane, int ldo = 0) {
    if (ldo == 0) ldo = K;
    const int nblk = N / 32, kb = item / nblk, nb = item % nblk, k0 = 64 * kb, n0 = 32 * nb;
    { f32x4 v[8];
#pragma unroll
      for (int i = 0; i < 8; ++i) v[i] = __builtin_nontemporal_load((const f32x4*)(W + (size_t)(k0 + i * 8 + (lane >> 3)) * N + n0 + 4 * (lane & 7)));
#pragma unroll
      for (int i = 0; i < 8; ++i) { LAS float* d = scr + (i * 8 + (lane >> 3)) * 33 + 4 * (lane & 7); d[0] = v[i][0]; d[1] = v[i][1]; d[2] = v[i][2]; d[3] = v[i][3]; } }
    asm volatile("s_waitcnt lgkmcnt(0)" ::: "memory");
    const int c = lane & 7;
#pragma unroll
    for (int j = 0; j < 4; ++j) { const int n = (lane >> 3) + 8 * j; const LAS float* s = scr + (8 * c) * 33 + n; const int ng = n0 + n;
        const int drow = mode == 0 ? ng : ((ng >> 4) * 32 + (ng & 15) + (mode == 2 ? 16 : 0));
        u32x4 o; o.x = pk2(s[0 * 33], s[1 * 33]); o.y = pk2(s[2 * 33], s[3 * 33]); o.z = pk2(s[4 * 33], s[5 * 33]); o.w = pk2(s[6 * 33], s[7 * 33]);
        *(u32x4*)(WT + (size_t)drow * ldo + k0 + 8 * c) = o; }
    asm volatile("s_waitcnt lgkmcnt(0)" ::: "memory");
}

DI void conv_item(KP p, LAS float* scr, int it, int lane) {
    unsigned char* ws = p->ws;
    constexpr int I_F = 1408, I_FFN = 3 * I_F * 8, I_MLQ = 16 * 96, I_SQ = 16 * 32, I_GMI = 16 * 64, I_VC = 8 * 32;
    int r = it;
    if (r < I_FFN) { const int lf = r / (3 * I_F), q = r % (3 * I_F), which = q / I_F, rr = q % I_F; bf16_t* d = (bf16_t*)(ws + WS_W + lf * FFN_BYTES);
        if (which == 0) tr_item(p->in[13] + (size_t)lf * DM * DFF, DM, DFF, d, 1, scr, rr, lane);
        else if (which == 1) tr_item(p->in[14] + (size_t)lf * DM * DFF, DM, DFF, d, 2, scr, rr, lane);
        else tr_item(p->in[15] + (size_t)lf * DM * DFF, DFF, DM, (bf16_t*)((unsigned char*)d + W13_BYTES), 0, scr, rr, lane, LDG);
        return; } r -= I_FFN;
    if (r < I_MLQ) { tr_item(p->in[16], DM, 3072, (bf16_t*)(ws + WS_MLQ), 0, scr, r, lane); return; } r -= I_MLQ;
    if (r < I_SQ) { tr_item(p->in[19], DM, DM, (bf16_t*)(ws + WS_MLQ) + (size_t)3072 * DM, 0, scr, r, lane); return; } r -= I_SQ;
    if (r < I_SQ) { tr_item(p->in[21], DM, DM, (bf16_t*)(ws + WS_MLO), 0, scr, r, lane); return; } r -= I_SQ;
    if (r < I_SQ) { tr_item(p->in[22], DM, DM, (bf16_t*)(ws + WS_FNO), 0, scr, r, lane); return; } r -= I_SQ;
    if (r < I_GMI) { tr_item(p->in[24], DM, 2048, (bf16_t*)(ws + WS_GMI), 0, scr, r, lane); return; } r -= I_GMI;
    if (r < I_SQ) { tr_item(p->in[29], DM, DM, (bf16_t*)(ws + WS_GMO), 0, scr, r, lane); return; } r -= I_SQ;
    if (r < I_MLQ) { tr_item(p->in[30], DM, 3072, (bf16_t*)(ws + WS_NAQ), 0, scr, r, lane); return; } r -= I_MLQ;
    if (r < I_SQ) { tr_item(p->in[31], DM, DM, (bf16_t*)(ws + WS_NAO), 0, scr, r, lane); return; } r -= I_SQ;
    { const int b = r / I_VC, rr = r % I_VC; tr_item(p->in[6] + (size_t)b * 512 * DM, 512, DM, (bf16_t*)(ws + WS_VCT) + (size_t)b * DM * 512, 0, scr, rr, lane); }
}
DI void conv_range(KP p, LAS unsigned char* lds, int wave, int lane, int lo, int hi, int rank, int nranks) {
    LAS float* scr = (LAS float*)(lds + wave * 16384);
    for (int it = lo + rank; it < hi; it += nranks) conv_item(p, scr, it, lane);
}

DI void prologue(KP p, LAS unsigned char* lds, int wave, int bid_) {
    const int lane = fresh_lane(), tid_ = wave * 64 + lane;
    unsigned char* ws = p->ws; const int G = gridDim.x, NGW = G * 8, gw = bid_ * 8 + wave; const int gt = bid_ * 512 + tid_, NT = G * 512;
    conv_range(p, lds, wave, lane, 0, 4224, gw, NGW); conv_range(p, lds, wave, lane, 33792, 33792 + 2560, gw, NGW); conv_range(p, lds, wave, lane, 33792 + 6656, 33792 + 7168, gw, NGW);
    { float* mods = (float*)(ws + WS_MODS);
      for (int it = gw; it < 4 * 16 * 36; it += NGW) { const int l = it / 576, r = it % 576, ks = r / 36, cb = r % 36, n0 = cb * 256 + 4 * lane;
          f32x4 a0 = {0.f, 0.f, 0.f, 0.f}, a1 = a0, a2 = a0;
          const float* w = p->in[9] + ((size_t)l * DM + ks * 64) * 9216 + n0;
#pragma unroll 8
          for (int k = 0; k < 64; ++k) { const int kk = ks * 64 + k; const f32x4 wv = __builtin_nontemporal_load((const f32x4*)(w + (size_t)k * 9216));
              const float s0 = fsilu(p->in[8][kk]), s1 = fsilu(p->in[7][kk]), s2 = fsilu(p->in[7][1024 + kk]); a0 += wv * s0; a1 += wv * s1; a2 += wv * s2; }
          if (ks == 0) { const f32x4 bv = *(const f32x4*)(p->in[10] + l * 9216 + n0); a0 += bv; a1 += bv; a2 += bv; }
          float* m0 = mods + (size_t)(l * 3) * 9216 + n0;
#pragma unroll
          for (int e = 0; e < 4; ++e) { __hip_atomic_fetch_add(m0 + e, a0[e], __ATOMIC_RELAXED, __HIP_MEMORY_SCOPE_AGENT); __hip_atomic_fetch_add(m0 + 9216 + e, a1[e], __ATOMIC_RELAXED, __HIP_MEMORY_SCOPE_AGENT);
              __hip_atomic_fetch_add(m0 + 2 * 9216 + e, a2[e], __ATOMIC_RELAXED, __HIP_MEMORY_SCOPE_AGENT); } } }
    { unsigned* t = (unsigned*)(ws + WS_DS2048);
      for (int i = gt; i < 4096 * 2048 / 2; i += NT) { const int r = i >> 10, s = (i & 1023) * 2, cs = r >> 11, sp = r & 2047; const int p0 = (s * sp) & 2047, p1 = ((s + 1) * sp) & 2047;
          const float a0 = p0 * (1.0f / 1024.0f), a1 = p1 * (1.0f / 1024.0f); t[i] = cs ? pk2(sinpif(a0), sinpif(a1)) : pk2(cospif(a0), cospif(a1)); }
      unsigned* t2 = (unsigned*)(ws + WS_DS256);
      for (int i = gt; i < 512 * 256 / 2; i += NT) { const int r = i >> 7, s = (i & 127) * 2, cs = r >> 8, sp = r & 255; const int p0 = (s * sp) & 255, p1 = ((s + 1) * sp) & 255;
          const float a0 = p0 * (1.0f / 128.0f), a1 = p1 * (1.0f / 128.0f); t2[i] = cs ? pk2(sinpif(a0), sinpif(a1)) : pk2(cospif(a0), cospif(a1)); }
      unsigned* t3 = (unsigned*)(ws + WS_DC);
      for (int i = gt; i < 256 * 512 / 2; i += NT) { const int cp = i >> 8, k = (i & 255) * 2, sn = k >> 8, c = k & 255; const int p0 = (c * cp) & 255, p1 = ((c + 1) * cp) & 255;
          const float a0 = p0 * (1.0f / 128.0f), a1 = p1 * (1.0f / 128.0f); t3[i] = sn ? pk2(-sinpif(a0), -sinpif(a1)) : pk2(cospif(a0), cospif(a1)); }
      unsigned* t4 = (unsigned*)(ws + WS_ABLK); const float* wsp = p->in[27];
      for (int i = gt; i < 4 * 256 * 256 / 2; i += NT) { const int g = i >> 15, r = (i >> 7) & 255, k = (i & 127) * 2; const bool on = (r >> 7) == (k >> 7);
          const float* s = wsp + ((size_t)g * 128 + (r & 127)) * 128 + (k & 127); t4[i] = on ? pk2(s[0], s[1]) : 0u; }
      unsigned* t5 = (unsigned*)(ws + WS_KC); const f32x2* ck = (const f32x2*)p->in[5];
      for (int i = gt; i < 2 * 512 * DM / 2; i += NT) { const f32x2 v = ck[i]; t5[i] = pk2(v.x, v.y); } }
}

DI void norm_row(KP p, int l, int idx, int row, int lane, f32x4 (&y)[4]) {
    const float* x = p->out + (size_t)row * DM; float ss = 0.f;
#pragma unroll
    for (int j = 0; j < 4; ++j) { y[j] = *(const f32x4*)(x + 4 * lane + 256 * j); ss += (y[j][0] * y[j][0] + y[j][1] * y[j][1]) + (y[j][2] * y[j][2] + y[j][3] * y[j][3]); }
    const float rstd = rsqrtf(wave_sum(ss, lane) * (1.0f / DM) + EPSN);
    const int cond = row < M_CTX ? 0 : 1 + ((row - M_CTX) >> 11);
    const float* md = (const float*)(p->ws + WS_MODS) + (size_t)(l * 3 + cond) * 9216 + (3 * idx) * DM; const float* g = p->in[11] + (size_t)(l * 3 + idx) * DM;
#pragma unroll
    for (int j = 0; j < 4; ++j) { const int c = 4 * lane + 256 * j; const f32x4 gv = *(const f32x4*)(g + c), sh = *(const f32x4*)(md + c), sc = *(const f32x4*)(md + DM + c);
        y[j] = (y[j] * rstd) * gv * (sc + 1.0f) + sh; }
}

DI void norm_phase(KP p, int l, int idx, int wave, int bid_) {
    const int lane = fresh_lane();
    const int G = gridDim.x, NGW = G * 8, gw = bid_ * 8 + wave; bf16_t* HB = (bf16_t*)(p->ws + WS_HB);
    const bool gates = (l == 0 && idx == 1), first = (l == 0 && idx == 0);
    const float* g = p->in[11] + (size_t)(l * 3 + idx) * DM;
    for (int base = gw * 6; base < M_TOK; base += NGW * 6) {
        int ccur = -1; f32x4 gs[4], shv[4];
#pragma unroll
        for (int j = 0; j < 4; ++j) { gs[j] = (f32x4){0.f, 0.f, 0.f, 0.f}; shv[j] = gs[j]; }
#pragma unroll
        for (int hh = 0; hh < 2; ++hh) {
            const int row0 = base + hh * 3;
            f32x4 y[3][4]; float ss[3];
#pragma unroll
            for (int q = 0; q < 3; ++q) { const int row = row0 + q; ss[q] = 0.f;
                if (row < M_TOK) { const float* x = first ? (row < M_CTX ? p->in[0] + (size_t)row * DM : p->in[1] + (size_t)(row - M_CTX) * DM) : p->out + (size_t)row * DM;
#pragma unroll
                    for (int j = 0; j < 4; ++j) y[q][j] = *(const f32x4*)(x + 8 * lane + 512 * (j >> 1) + 4 * (j & 1)); }
                else {
#pragma unroll
                    for (int j = 0; j < 4; ++j) y[q][j] = (f32x4){0.f, 0.f, 0.f, 0.f}; } }
#pragma unroll
            for (int q = 0; q < 3; ++q) {
#pragma unroll
                for (int j = 0; j < 4; ++j) ss[q] += (y[q][j][0] * y[q][j][0] + y[q][j][1] * y[q][j][1]) + (y[q][j][2] * y[q][j][2] + y[q][j][3] * y[q][j][3]); }
#pragma unroll
            for (int o = 1; o < 64; o <<= 1) {
#pragma unroll
                for (int q = 0; q < 3; ++q) ss[q] += shx(ss[q], o, lane); }
#pragma unroll
            for (int q = 0; q < 3; ++q) { const int row = row0 + q; if (row >= M_TOK) continue;
                const float rstd = rsqrtf(ss[q] * (1.0f / DM) + EPSN);
                const int cond = row < M_CTX ? 0 : 1 + ((row - M_CTX) >> 11);
                if (cond != ccur) { ccur = cond; const float* md = (const float*)(p->ws + WS_MODS) + (size_t)(l * 3 + cond) * 9216 + (3 * idx) * DM;
#pragma unroll
                    for (int j = 0; j < 4; ++j) { const int c = 8 * lane + 512 * (j >> 1) + 4 * (j & 1); gs[j] = *(const f32x4*)(g + c) * (*(const f32x4*)(md + DM + c) + 1.0f); shv[j] = *(const f32x4*)(md + c); } }
#pragma unroll
                for (int j = 0; j < 4; ++j) y[q][j] = (y[q][j] * rstd) * gs[j] + shv[j];
#pragma unroll
                for (int jj = 0; jj < 2; ++jj) { u32x4 w; w.x = pk2(y[q][2 * jj][0], y[q][2 * jj][1]); w.y = pk2(y[q][2 * jj][2], y[q][2 * jj][3]); w.z = pk2(y[q][2 * jj + 1][0], y[q][2 * jj + 1][1]); w.w = pk2(y[q][2 * jj + 1][2], y[q][2 * jj + 1][3]);
                    *(u32x4*)(HB + (size_t)row * DM + 8 * lane + 512 * jj) = w; }
                if (gates) {
                    float a[16];
#pragma unroll
                    for (int o = 0; o < 16; ++o) a[o] = 0.f;
                    const float* wif = p->in[17];
#pragma unroll
                    for (int j = 0; j < 4; ++j)
#pragma unroll
                        for (int e = 0; e < 4; ++e) { const int c = 8 * lane + 512 * (j >> 1) + 4 * (j & 1) + e; const float yv = y[q][j][e];
#pragma unroll
                            for (int d = 0; d < 2; ++d) { const f32x4 w0 = *(const f32x4*)(wif + ((size_t)d * DM + c) * 8), w1 = *(const f32x4*)(wif + ((size_t)d * DM + c) * 8 + 4);
#pragma unroll
                                for (int o = 0; o < 4; ++o) { a[d * 8 + o] += yv * w0[o]; a[d * 8 + 4 + o] += yv * w1[o]; } } }
                    float sel = 0.f;
#pragma unroll
                    for (int o = 0; o < 16; ++o) { const float t = wave_sum(a[o], lane); sel = (lane == o) ? t : sel; }
                    if (lane < 16) { float v = sel + p->in[18][lane]; if ((lane & 7) >= 4) v = logsigmoidf(v); ((float*)(p->ws + WS_IFG))[(size_t)row * 16 + lane] = v; }
                }
            }
        }
    }
}

DI void tile_T_write(LAS unsigned char* lds, bf16_t* dst, int tok0, int tid_) {
    __syncthreads();
    const int cp = tid_;
#pragma unroll
    for (int tg = 0; tg < 8; ++tg) { unsigned v[8];
#pragma unroll
        for (int i = 0; i < 8; ++i) v[i] = *(const LAS unsigned*)(lds + (tg * 8 + i) * 2048 + cp * 4);
        u32x4 lo, hi;
        lo.x = (v[0] & 0xffffu) | (v[1] << 16); lo.y = (v[2] & 0xffffu) | (v[3] << 16); lo.z = (v[4] & 0xffffu) | (v[5] << 16); lo.w = (v[6] & 0xffffu) | (v[7] << 16);
        hi.x = (v[0] >> 16) | (v[1] & 0xffff0000u); hi.y = (v[2] >> 16) | (v[3] & 0xffff0000u); hi.z = (v[4] >> 16) | (v[5] & 0xffff0000u); hi.w = (v[6] >> 16) | (v[7] & 0xffff0000u);
        *(u32x4*)(dst + (size_t)(2 * cp) * M_TOK + tok0 + tg * 8) = lo; *(u32x4*)(dst + (size_t)(2 * cp + 1) * M_TOK + tok0 + tg * 8) = hi; }
    __syncthreads();
}
DI void normT_phase(KP p, LAS unsigned char* lds, int l, int idx, int wave, int bid_) {
    const int lane = fresh_lane(), tid_ = wave * 64 + lane;
    bf16_t* HT = (bf16_t*)(p->ws + WS_SCR + SCR_HT);
    for (int blk = bid_; blk < M_TOK / 64; blk += gridDim.x) {
        for (int i = 0; i < 8; ++i) { const int rt = wave * 8 + i; f32x4 y[4]; norm_row(p, l, idx, blk * 64 + rt, lane, y);
#pragma unroll
            for (int j = 0; j < 4; ++j) { u32x2 w; w.x = pk2(y[j][0], y[j][1]); w.y = pk2(y[j][2], y[j][3]); *(LAS u32x2*)(lds + rt * 2048 + (4 * lane + 256 * j) * 2) = w; } }
        tile_T_write(lds, HT, blk * 64, tid_);
    }
}
DI void gtrans_phase(KP p, LAS unsigned char* lds, int wave, int bid_) {
    const int lane = fresh_lane(), tid_ = wave * 64 + lane;
    const bf16_t* V = (const bf16_t*)(p->ws + WS_SCR + SCR_V); bf16_t* VNT = (bf16_t*)(p->ws + WS_SCR + SCR_VNT);
    for (int blk = bid_; blk < M_TOK / 64; blk += gridDim.x) {
        for (int i = 0; i < 8; ++i) { const int rt = wave * 8 + i; const bf16_t* vr = V + (size_t)(blk * 64 + rt) * DM; u32x2 w[4]; float ss = 0.f;
#pragma unroll
            for (int j = 0; j < 4; ++j) { w[j] = *(const u32x2*)(vr + 4 * lane + 256 * j); const float a = bflo(w[j].x), b = bfhi(w[j].x), c = bflo(w[j].y), d = bfhi(w[j].y); ss += (a * a + b * b) + (c * c + d * d); }
            const float rstd = rsqrtf(wave_sum(ss, lane) * (1.0f / DM) + EPSN);
#pragma unroll
            for (int j = 0; j < 4; ++j) { u32x2 o; o.x = pk2(bflo(w[j].x) * rstd, bfhi(w[j].x) * rstd); o.y = pk2(bflo(w[j].y) * rstd, bfhi(w[j].y) * rstd); *(LAS u32x2*)(lds + rt * 2048 + (4 * lane + 256 * j) * 2) = o; } }
        tile_T_write(lds, VNT, blk * 64, tid_);
    }
}
DI void final_phase(KP p, int wave, int bid_) {
    const int lane = fresh_lane();
    const int NGW = gridDim.x * 8, gw = bid_ * 8 + wave; const float* g = p->in[12];
    f32x4 gvv[4];
#pragma unroll
    for (int j = 0; j < 4; ++j) gvv[j] = *(const f32x4*)(g + 4 * lane + 256 * j);
    for (int row0 = gw; row0 < M_TOK; row0 += 3 * NGW) {
        f32x4 y[3][4]; float ss[3];
#pragma unroll
        for (int q = 0; q < 3; ++q) { const int row = row0 + q * NGW; ss[q] = 0.f;
            if (row < M_TOK) { const float* x = p->out + (size_t)row * DM;
#pragma unroll
                for (int j = 0; j < 4; ++j) y[q][j] = *(const f32x4*)(x + 4 * lane + 256 * j); }
            else {
#pragma unroll
                for (int j = 0; j < 4; ++j) y[q][j] = (f32x4){0.f, 0.f, 0.f, 0.f}; } }
#pragma unroll
        for (int q = 0; q < 3; ++q) {
#pragma unroll
            for (int j = 0; j < 4; ++j) ss[q] += (y[q][j][0] * y[q][j][0] + y[q][j][1] * y[q][j][1]) + (y[q][j][2] * y[q][j][2] + y[q][j][3] * y[q][j][3]); }
#pragma unroll
        for (int o = 1; o < 64; o <<= 1) {
#pragma unroll
            for (int q = 0; q < 3; ++q) ss[q] += shx(ss[q], o, lane); }
#pragma unroll
        for (int q = 0; q < 3; ++q) { const int row = row0 + q * NGW; if (row >= M_TOK) continue; float* x = p->out + (size_t)row * DM;
            const float rstd = rsqrtf(ss[q] * (1.0f / DM) + EPSN);
#pragma unroll
            for (int j = 0; j < 4; ++j) __builtin_nontemporal_store((y[q][j] * rstd) * gvv[j], (f32x4*)(x + 4 * lane + 256 * j)); }
    }
}

DI void chunk_scan(const float* ifg, int tc, int dir, int h, int lane, float& i0, float& i1, float& b0, float& b1, float& blast) {
    const float* r0 = ifg + (size_t)(tc + 2 * lane) * 16 + dir * 8 + h; i0 = r0[0]; i1 = r0[16]; const float f0 = r0[4], f1 = r0[20];
    float inc = f0 + f1;
    if (dir == 0) {
#pragma unroll
        for (int o = 1; o < 64; o <<= 1) { const float t = bperm(lane - o, inc); if (lane >= o) inc += t; }
        float ex = bperm(lane - 1, inc); if (lane == 0) ex = 0.f; b0 = ex + f0; b1 = inc; blast = bperm(63, inc);
    } else {
#pragma unroll
        for (int o = 1; o < 64; o <<= 1) { const float t = bperm(lane + o, inc); if (lane + o < 64) inc += t; }
        float ex = bperm(lane + 1, inc); if (lane == 63) ex = 0.f; b1 = ex + f1; b0 = inc; blast = bperm(0, inc);
    }
}
DI int ml_sidx(bool lat, int b, int h, int dir, int ci) { return lat ? (((b * 4 + h) * 2 + dir) * 16 + ci) : (256 + ((b * 4 + h) * 2 + dir)); }

DI void ml1_job(KP p, LAS unsigned char* lds, int wave, int lane, int tid_, bool lat, int v) {
    unsigned char* ws = p->ws; const int fr = lane & 15, fq = lane >> 4;
    LAS float* wsc = (LAS float*)(lds + 69632 + wave * 2048); const unsigned lofT0 = (unsigned)(fr * M_TOK + 8 * fq) * 2u, lofS0 = (unsigned)(4 * fq * 256 + fr) * 2u;
    const float* ifg = (const float*)(ws + WS_IFG); const bf16_t* KT = (const bf16_t*)(ws + WS_SCR + SCR_KT); const bf16_t* VT = (const bf16_t*)(ws + WS_SCR + SCR_VT);
    float* mlst = (float*)(ws + WS_MLST);
    const int dvh = v & 1, dkh = (v >> 1) & 1, dir = (v >> 2) & 1, h = (v >> 3) & 3, b = v >> 5; const int dv0 = dvh * 128;
    const int tok0 = lat ? M_CTX + b * 2048 : b * 256, nch = lat ? 16 : 2, ncomp = lat ? 15 : 2; const int dk0 = dkh * 128 + wave * 16;
    f32x4 acc[8]; float nst; float mst;
    if (lat) { const int si = (b * 2 + dir) * 4 + h; const float* C0 = p->in[2] + (size_t)si * 65536; const float* n0 = p->in[3] + (size_t)si * 256; mst = p->in[4][si];
        int l3 = lane; asm volatile("" : "+v"(l3)); const int fr3 = l3 & 15, fq3 = l3 >> 4;
        nst = n0[dk0 + fr3];
#pragma unroll
        for (int dvb = 0; dvb < 8; ++dvb) acc[dvb] = *(const f32x4*)(C0 + (size_t)(dk0 + fr3) * 256 + dv0 + dvb * 16 + 4 * fq3);
    } else { mst = 0.f; nst = 0.f;
#pragma unroll
        for (int dvb = 0; dvb < 8; ++dvb) acc[dvb] = (f32x4){0.f, 0.f, 0.f, 0.f}; }
    u32x4 pre[4];
    { int tl = tid_; asm volatile("" : "+v"(tl)); const int oc = dir ? nch - 1 : 0; const unsigned char* src = (const unsigned char*)(VT + (size_t)(h * 256 + dv0) * M_TOK + tok0 + oc * 128);
#pragma unroll
      for (int i = 0; i < 4; ++i) { const int idx = i * 512 + tl, row = idx >> 4, c = idx & 15; pre[i] = *(const u32x4*)(src + (size_t)row * (M_TOK * 2) + c * 16); } }
    for (int ci = 0; ci <= ncomp; ++ci) {
        if (ci > 0 || lat) {
            if (lat || ci < nch) {
            unsigned lofS = lofS0; asm volatile("" : "+v"(lofS));
            const int sidx = ml_sidx(lat, b, h, dir, ci); bf16_t* sn = (bf16_t*)(ws + WS_SCR + SCR_SNAP) + (size_t)sidx * 65536; float* st = mlst + (size_t)sidx * MLST_STRIDE;
            gwp ps = (gwp)(sn + (size_t)dv0 * 256 + dk0) + lofS;
#pragma unroll
            for (int dvb = 0; dvb < 8; ++dvb) {
#pragma unroll
                for (int r = 0; r < 4; ++r) *(GAS bf16_t*)(ps + r * 512) = (bf16_t)(pk2(acc[dvb][r], 0.f) & 0xffffu);
                ps += 16 * 512; asm volatile("" : "+v"(ps)); }
            if (fq == 0 && dvh == 0) st[dk0 + fr] = nst;
            if (dvh == 0 && dkh == 0 && wave == 0 && lane == 0) st[256] = mst; }
        }
        if (ci == ncomp) break;
        const int oc = dir ? nch - 1 - ci : ci, tc = tok0 + oc * 128;
        __syncthreads();
        { int tl = tid_; asm volatile("" : "+v"(tl));
#pragma unroll
          for (int i = 0; i < 4; ++i) { const int idx = i * 512 + tl, row = idx >> 4, c = idx & 15; *(LAS u32x4*)(lds + row * 272 + c * 16) = pre[i]; } }
        __syncthreads();
        if (ci + 1 < ncomp) { int tl = tid_; asm volatile("" : "+v"(tl)); const int oc2 = dir ? nch - 2 - ci : ci + 1; const unsigned char* src = (const unsigned char*)(VT + (size_t)(h * 256 + dv0) * M_TOK + tok0 + oc2 * 128);
#pragma unroll
            for (int i = 0; i < 4; ++i) { const int idx = i * 512 + tl, row = idx >> 4, c = idx & 15; pre[i] = *(const u32x4*)(src + (size_t)row * (M_TOK * 2) + c * 16); } }
        unsigned lofT = lofT0; asm volatile("" : "+v"(lofT));
        float i0, i1, b0, b1, blast; chunk_scan(ifg, tc, dir, h, lane, i0, i1, b0, b1, blast);
        const float g0 = blast - b0 + i0, g1 = blast - b1 + i1; const float mloc = wave_max(fmaxf(g0, g1), lane); const float mnew = fmaxf(blast + mst, mloc);
        wsc[2 * lane] = __expf(g0 - mnew); wsc[2 * lane + 1] = __expf(g1 - mnew); const float decay = __expf(blast + mst - mnew);
#pragma unroll
        for (int dvb = 0; dvb < 8; ++dvb) acc[dvb] *= decay;
        bf16x8 Bf[4]; float nsum = 0.f;
#pragma unroll
        for (int ks = 0; ks < 4; ++ks) { const f32x4 w0 = *(const LAS f32x4*)(wsc + ks * 32 + 8 * fq), w1 = *(const LAS f32x4*)(wsc + ks * 32 + 8 * fq + 4);
            const u32x4 kv = __builtin_bit_cast(u32x4, ldf16(KT + (size_t)(h * 256 + dk0) * M_TOK + tc + ks * 32, lofT));
            const float e0 = bflo(kv.x) * w0[0], e1 = bfhi(kv.x) * w0[1], e2 = bflo(kv.y) * w0[2], e3 = bfhi(kv.y) * w0[3], e4 = bflo(kv.z) * w1[0], e5 = bfhi(kv.z) * w1[1], e6 = bflo(kv.w) * w1[2], e7 = bfhi(kv.w) * w1[3];
            nsum += ((e0 + e1) + (e2 + e3)) + ((e4 + e5) + (e6 + e7));
            u32x4 o; o.x = pk2(e0, e1); o.y = pk2(e2, e3); o.z = pk2(e4, e5); o.w = pk2(e6, e7); Bf[ks] = __builtin_bit_cast(bf16x8, o); }
        const LAS unsigned char* lv = lds + fr * 272 + fq * 16;
#pragma unroll
        for (int dvb = 0; dvb < 8; ++dvb) {
            if ((dvb & 3) == 0) __builtin_amdgcn_sched_barrier(0);
#pragma unroll
            for (int ks = 0; ks < 4; ++ks) { const bf16x8 A = *(const LAS bf16x8*)(lv + dvb * (16 * 272) + ks * 64); acc[dvb] = MFMA16(A, Bf[ks], acc[dvb]); } }
        __builtin_amdgcn_sched_barrier(0);
        { float s2 = nsum; s2 += shx(s2, 16, lane); s2 += shx(s2, 32, lane); nst = decay * nst + s2; }
        mst = mnew;
    }
    if (!lat) { const int si = (b * 2 + dir) * 4 + h; float* Co = p->out + O_C + (size_t)si * 65536; float* no = p->out + O_N + (size_t)si * 256;
        int l2 = lane; asm volatile("" : "+v"(l2)); const int fr2 = l2 & 15, fq2 = l2 >> 4;
#pragma unroll
        for (int dvb = 0; dvb < 8; ++dvb) __builtin_nontemporal_store(acc[dvb], (f32x4*)(Co + (size_t)(dk0 + fr2) * 256 + dv0 + dvb * 16 + 4 * fq2));
        if (fq2 == 0 && dvh == 0) no[dk0 + fr2] = nst;
        if (dvh == 0 && dkh == 0 && wave == 0 && l2 == 0) p->out[O_M + si] = mst; }
}
DI void ml1_phase(KP p, LAS unsigned char* lds, int wave, int bid_) {
    const int lane = fresh_lane(), tid_ = wave * 64 + lane;
    const int G = gridDim.x;
    if (G >= 128) {
        if (bid_ < 64) ml1_job(p, lds, wave, lane, tid_, true, bid_);
        else for (int c = bid_ - 64; c < 1024; c += G - 64) ml1_job(p, lds, wave, lane, tid_, false, c);
    } else {
        for (int j = bid_; j < 1088; j += G) ml1_job(p, lds, wave, lane, tid_, j < 64, j < 64 ? j : j - 64);
    }
    __syncthreads();
}

constexpr int ML2_VT = 0, ML2_B = 69632, ML2_SC = 137216;
DI void ml2_stage512(LAS unsigned char* dst, const unsigned char* src, size_t stride, int tid_) {
    asm volatile("" : "+v"(tid_));
#pragma unroll
    for (int hh = 0; hh < 2; ++hh) { u32x4 v[4];
#pragma unroll
        for (int i = 0; i < 4; ++i) { const int idx = (hh * 4 + i) * 512 + tid_, row = idx >> 5, c = idx & 31; v[i] = *(const u32x4*)(src + (size_t)row * stride + c * 16); }
#pragma unroll
        for (int i = 0; i < 4; ++i) { const int idx = (hh * 4 + i) * 512 + tid_, row = idx >> 5, c = idx & 31; *(LAS u32x4*)(dst + row * 528 + c * 16) = v[i]; }
        __builtin_amdgcn_sched_barrier(0); }
}
DI void ml2_phase(KP p, LAS unsigned char* lds, int wave, int bid_) {
    const int lane_in = fresh_lane(), tid_ = wave * 64 + lane_in;
    unsigned char* ws = p->ws; const int lane0 = lane_in;
    const float* ifg = (const float*)(ws + WS_IFG); const bf16_t* Q = (const bf16_t*)(ws + WS_SCR + SCR_Q); const bf16_t* Kn = (const bf16_t*)(ws + WS_SCR + SCR_K);
    const bf16_t* VT = (const bf16_t*)(ws + WS_SCR + SCR_VT); const bf16_t* OG = (const bf16_t*)(ws + WS_SCR + SCR_OG); bf16_t* HB = (bf16_t*)(ws + WS_HB);
    const float* mlst = (const float*)(ws + WS_MLST);
    const bool deal = gridDim.x == 256; const int nmine = deal ? (bid_ < 128 ? 2 : 1) : 0;
    for (int ui_ = 0, uu = deal ? (bid_ < 128 ? 2 * bid_ : 128 + bid_) : bid_; deal ? (ui_ < nmine) : (uu < 384); ++ui_, uu += deal ? 1 : (int)gridDim.x) {
        int lane = lane0; asm volatile("" : "+v"(lane));
        const int fr = lane & 15, fq = lane >> 4; const unsigned lofK0 = (unsigned)(fr * DM + 8 * fq) * 2u;
        LAS float* bb = (LAS float*)(lds + ML2_SC + wave * 2048); LAS float* ib = bb + 128; LAS float* mt = bb + 256;
        const bool lat = uu >= 256; const int v = lat ? uu - 256 : uu; const int oc = lat ? (v & 15) : (v & 1), h = lat ? ((v >> 4) & 3) : ((v >> 1) & 3), b = lat ? (v >> 6) : (v >> 3);
        const int tok0 = lat ? M_CTX + b * 2048 : b * 256, nch = lat ? 16 : 2, tc = tok0 + oc * 128, tw = wave * 16;
        __syncthreads();
        { u32x4 vv[8]; const unsigned char* src = (const unsigned char*)(VT + (size_t)(h * 256) * M_TOK + tc); int tl = tid_; asm volatile("" : "+v"(tl));
#pragma unroll
          for (int i = 0; i < 8; ++i) { const int idx = i * 512 + tl, row = idx >> 4, c = idx & 15; vv[i] = *(const u32x4*)(src + (size_t)row * (M_TOK * 2) + c * 16); }
#pragma unroll
          for (int i = 0; i < 8; ++i) { const int idx = i * 512 + tl, row = idx >> 4, c = idx & 15; *(LAS u32x4*)(lds + ML2_VT + row * 272 + c * 16) = vv[i]; } }
        f32x4 hs[16];
#pragma unroll
        for (int d = 0; d < 16; ++d) hs[d] = (f32x4){0.f, 0.f, 0.f, 0.f};
        for (int dir = 0; dir < 2; ++dir) {
            unsigned lofK = lofK0; asm volatile("" : "+v"(lofK));
            int tcl = tc; asm volatile("" : "+s"(tcl));
            if (dir == 1) __syncthreads();
            ml2_stage512(lds + ML2_B, (const unsigned char*)(Kn + (size_t)tcl * DM + h * 256), DM * 2, tid_);
            const int ci = dir ? nch - 1 - oc : oc; const bool zero = (!lat && ci == 0); const int sidx = ml_sidx(lat, b, h, dir, ci);
            const float* st = mlst + (size_t)sidx * MLST_STRIDE; const float mprev = zero ? 0.f : st[256];
            { float i0, i1, b0, b1, blast; chunk_scan(ifg, tcl, dir, h, lane, i0, i1, b0, b1, blast);
              const float x0 = i0 - b0, x1 = i1 - b1; float inc = fmaxf(x0, x1), M0, M1;
              if (dir == 0) {
#pragma unroll
                  for (int o = 1; o < 64; o <<= 1) { const float t = bperm(lane - o, inc); if (lane >= o) inc = fmaxf(inc, t); }
                  float ex = bperm(lane - 1, inc); if (lane == 0) ex = -INFINITY; M0 = fmaxf(ex, x0); M1 = inc;
              } else {
#pragma unroll
                  for (int o = 1; o < 64; o <<= 1) { const float t = bperm(lane + o, inc); if (lane + o < 64) inc = fmaxf(inc, t); }
                  float ex = bperm(lane + 1, inc); if (lane == 63) ex = -INFINITY; M1 = fmaxf(ex, x1); M0 = inc;
              }
              bb[2 * lane] = b0; bb[2 * lane + 1] = b1; ib[2 * lane] = x0; ib[2 * lane + 1] = x1; mt[2 * lane] = b0 + fmaxf(mprev, M0); mt[2 * lane + 1] = b1 + fmaxf(mprev, M1); }
            bf16x8 qf[8];
#pragma unroll
            for (int ks = 0; ks < 8; ++ks) qf[ks] = ldf16(Q + (size_t)(tcl + tw) * DM + h * 256 + ks * 32, lofK);
            __syncthreads();
            const float bt = bb[tw + fr], mtt = mt[tw + fr];
            f32x4 S[8];
            const LAS unsigned char* lk = lds + ML2_B + fr * 528 + fq * 16;
#pragma unroll
            for (int sb = 0; sb < 8; ++sb) { S[sb] = (f32x4){0.f, 0.f, 0.f, 0.f}; __builtin_amdgcn_sched_barrier(0);
                if (dir ? (sb >= wave) : (sb <= wave)) {
#pragma unroll
                    for (int ks = 0; ks < 8; ++ks) { const bf16x8 A = *(const LAS bf16x8*)(lk + sb * (16 * 528) + ks * 64); S[sb] = MFMA16(A, qf[ks], S[sb]); } } }
            float dsum = 0.f; int t = tw + fr; asm volatile("" : "+v"(t)); const float e0 = bt - mtt; const int dsgn = dir ? -1 : 1;
#pragma unroll
            for (int sb = 0; sb < 8; ++sb) { const f32x4 iv = *(const LAS f32x4*)(ib + sb * 16 + 4 * fq);
#pragma unroll
                for (int r = 0; r < 4; ++r) { const int s2 = sb * 16 + 4 * fq + r; const int sg = dsgn * (s2 - t); const float pen = (float)max(sg, 0) * -1e30f; const float a = S[sb][r] * __expf(e0 + iv[r] + pen); S[sb][r] = a; dsum += a; } }
            bf16x8 aT[4];
#pragma unroll
            for (int kp = 0; kp < 4; ++kp) { u32x4 o; o.x = pk2(S[2 * kp][0], S[2 * kp][1]); o.y = pk2(S[2 * kp][2], S[2 * kp][3]); o.z = pk2(S[2 * kp + 1][0], S[2 * kp + 1][1]); o.w = pk2(S[2 * kp + 1][2], S[2 * kp + 1][3]); aT[kp] = __builtin_bit_cast(bf16x8, o); }
            dsum += shx(dsum, 16, lane); dsum += shx(dsum, 32, lane);
            const float winter = __expf(bt + mprev - mtt);
            float qn = 0.f;
            if (!zero) {
#pragma unroll
                for (int ks = 0; ks < 8; ++ks) { const f32x4 n0 = *(const f32x4*)(st + ks * 32 + 8 * fq), n1 = *(const f32x4*)(st + ks * 32 + 8 * fq + 4); const u32x4 qq = __builtin_bit_cast(u32x4, qf[ks]);
                    qn += (bflo(qq.x) * n0[0] + bfhi(qq.x) * n0[1]) + (bflo(qq.y) * n0[2] + bfhi(qq.y) * n0[3]) + (bflo(qq.z) * n1[0] + bfhi(qq.z) * n1[1]) + (bflo(qq.w) * n1[2] + bfhi(qq.w) * n1[3]); }
                qn += shx(qn, 16, lane); qn += shx(qn, 32, lane); }
            const float den = dsum + winter * qn; const float inv = 1.0f / fmaxf(fabsf(den), __expf(-mtt));
            const unsigned char* sn = ws + WS_SCR + SCR_SNAP + (size_t)sidx * 131072;
            if (!zero) {
#pragma unroll
                for (int ks = 0; ks < 8; ++ks) qf[ks] = ldf16(Q + (size_t)(tcl + tw) * DM + h * 256 + ks * 32, lofK);
            }
            const LAS unsigned char* lv = lds + ML2_VT + fr * 272 + fq * 8;
            const LAS unsigned char* lc = lds + ML2_B + fr * 528 + fq * 16;
#pragma unroll
            for (int half = 0; half < 2; ++half) {
                if (!zero) { __syncthreads(); ml2_stage512(lds + ML2_B, sn + half * 65536, 512, tid_); __syncthreads(); }
#pragma unroll
                for (int d8 = 0; d8 < 8; ++d8) { const int dvb = half * 8 + d8; __builtin_amdgcn_sched_barrier(0);
                    f32x4 num = {0.f, 0.f, 0.f, 0.f}, num2 = {0.f, 0.f, 0.f, 0.f};
#pragma unroll
                    for (int kp = 0; kp < 4; ++kp) { const u32x2 lo = *(const LAS u32x2*)(lv + dvb * (16 * 272) + kp * 64), hi = *(const LAS u32x2*)(lv + dvb * (16 * 272) + kp * 64 + 32); u32x4 a; a.x = lo.x; a.y = lo.y; a.z = hi.x; a.w = hi.y;
                        num = MFMA16(__builtin_bit_cast(bf16x8, a), aT[kp], num); }
                    if (!zero) {
#pragma unroll
                        for (int ks = 0; ks < 8; ++ks) { const bf16x8 A = *(const LAS bf16x8*)(lc + d8 * (16 * 528) + ks * 64); num2 = MFMA16(A, qf[ks], num2); } }
                    hs[dvb] += (num + num2 * winter) * inv; asm volatile("" : "+v"(hs[dvb])); }
            }
        }
        float ss = 0.f;
#pragma unroll
        for (int d = 0; d < 16; ++d) ss += (hs[d][0] * hs[d][0] + hs[d][1] * hs[d][1]) + (hs[d][2] * hs[d][2] + hs[d][3] * hs[d][3]);
        ss += shx(ss, 16, lane); ss += shx(ss, 32, lane);
        const float rstd = rsqrtf(ss * (1.0f / 256.0f) + EPSN); const size_t ro = (size_t)(tc + tw + fr) * DM + h * 256;
#pragma unroll
        for (int d = 0; d < 16; ++d) { if ((d & 3) == 0) __builtin_amdgcn_sched_barrier(0); const int c = d * 16 + 4 * fq; const f32x4 hg = *(const f32x4*)(p->in[20] + h * 256 + c); const u32x2 og = *(const u32x2*)(OG + ro + c);
            u32x2 w; w.x = pk2(hs[d][0] * rstd * hg[0] * bflo(og.x), hs[d][1] * rstd * hg[1] * bfhi(og.x)); w.y = pk2(hs[d][2] * rstd * hg[2] * bflo(og.y), hs[d][3] * rstd * hg[3] * bfhi(og.y));
            *(u32x2*)(HB + ro + c) = w; }
    }
    __syncthreads();
}

template <int MODE>
DI void attn_chunk(f32x4 (&O)[4], float& mrun, float& lrun, const bf16x8 (&qf)[2], int fr, int fq,
                   const LAS unsigned char* lk, const LAS unsigned char* lv, int vrow, int key0,
                   const bf16_t* kwin, const bf16_t* vwin, int h, const float* rpb, int yrel0, int col_start, int qc, int qstart) {
    const int lane = fq * 16 + fr;
    f32x4 S[8];
#pragma unroll
    for (int seg = 0; seg < 4; ++seg)
#pragma unroll
        for (int hb = 0; hb < 2; ++hb) { f32x4 sacc = {0.f, 0.f, 0.f, 0.f};
#pragma unroll
            for (int ks = 0; ks < 2; ++ks) { bf16x8 A;
                if (MODE == 0) A = *(const LAS bf16x8*)(lk + (key0 + seg * 32 + hb * 16 + fr) * 144 + ks * 64 + fq * 16);
                else A = *(const bf16x8*)(kwin + (size_t)(seg * 64 + hb * 16 + fr) * DM + h * 64 + ks * 32 + 8 * fq);
                sacc = MFMA16(A, qf[ks], sacc); }
            S[seg * 2 + hb] = sacc; }
    if (MODE == 1) {
#pragma unroll
        for (int seg = 0; seg < 4; ++seg) { const float* rb = rpb + (yrel0 + seg) * 31;
#pragma unroll
            for (int hb = 0; hb < 2; ++hb)
#pragma unroll
                for (int e = 0; e < 4; ++e) { const int kc = col_start + hb * 16 + 4 * fq + e; const bool valid = (kc >= qstart) && (kc < qstart + 16); const int dc = min(max(kc - qc + 15, 0), 30);
                    S[seg * 2 + hb][e] = valid ? S[seg * 2 + hb][e] + rb[dc] : -INFINITY; } } }
    float cm = -INFINITY;
#pragma unroll
    for (int i = 0; i < 8; ++i) cm = fmaxf(cm, fmaxf(fmaxf(S[i][0], S[i][1]), fmaxf(S[i][2], S[i][3])));
    cm = fmaxf(cm, shx(cm, 16, lane)); cm = fmaxf(cm, shx(cm, 32, lane));
    const float mnew = fmaxf(mrun, cm), alpha = __expf(mrun - mnew); mrun = mnew; float ps = 0.f;
#pragma unroll
    for (int i = 0; i < 8; ++i)
#pragma unroll
        for (int e = 0; e < 4; ++e) { const float pv = __expf(S[i][e] - mnew); S[i][e] = pv; ps += pv; }
    lrun = lrun * alpha + ps;
#pragma unroll
    for (int d = 0; d < 4; ++d) O[d] *= alpha;
#pragma unroll
    for (int seg = 0; seg < 4; ++seg) {
        u32x4 o; o.x = pk2(S[2 * seg][0], S[2 * seg][1]); o.y = pk2(S[2 * seg][2], S[2 * seg][3]); o.z = pk2(S[2 * seg + 1][0], S[2 * seg + 1][1]); o.w = pk2(S[2 * seg + 1][2], S[2 * seg + 1][3]);
        const bf16x8 pT = __builtin_bit_cast(bf16x8, o);
#pragma unroll
        for (int d = 0; d < 4; ++d) { u32x2 lo, hi;
            if (MODE == 0) { const LAS unsigned char* a = lv + (d * 16 + fr) * vrow + (key0 + seg * 32) * 2 + fq * 8; lo = *(const LAS u32x2*)a; hi = *(const LAS u32x2*)(a + 32); }
            else { const bf16_t* a = vwin + (size_t)(h * 64 + d * 16 + fr) * M_TOK + seg * 64 + 4 * fq; lo = *(const u32x2*)a; hi = *(const u32x2*)(a + 16); }
            u32x4 av; av.x = lo.x; av.y = lo.y; av.z = hi.x; av.w = hi.y;
            O[d] = MFMA16(__builtin_bit_cast(bf16x8, av), pT, O[d]); } }
}
DI void attn_store(bf16_t* HB, f32x4 (&O)[4], float lrun, int qtok, int h, int fr, int fq) {
    const int lane = fq * 16 + fr;
    lrun += shx(lrun, 16, lane); lrun += shx(lrun, 32, lane); const float inv = 1.0f / lrun;
#pragma unroll
    for (int d = 0; d < 4; ++d) { u32x2 w; w.x = pk2(O[d][0] * inv, O[d][1] * inv); w.y = pk2(O[d][2] * inv, O[d][3] * inv); *(u32x2*)(HB + (size_t)(qtok + fr) * DM + h * 64 + d * 16 + 4 * fq) = w; }
}
constexpr int ATT_LK = 0, ATT_LV = 73728;
DI void attn_phase(KP p, LAS unsigned char* lds, int wave, int bid_) {
    const int lane = fresh_lane(), tid_ = wave * 64 + lane;
    unsigned char* ws = p->ws; const int G = gridDim.x; const int fr = lane & 15, fq = lane >> 4;
    const bf16_t* Q = (const bf16_t*)(ws + WS_SCR + SCR_Q); const bf16_t* Kn = (const bf16_t*)(ws + WS_SCR + SCR_K); const bf16_t* VT = (const bf16_t*)(ws + WS_SCR + SCR_VT);
    const bf16_t* KC = (const bf16_t*)(ws + WS_KC); const bf16_t* VCT = (const bf16_t*)(ws + WS_VCT); bf16_t* HB = (bf16_t*)(ws + WS_HB);
    for (int job = bid_; job < 256; job += G) {
        const int bh = job & 31, sl = job >> 5, b = bh >> 4, h = bh & 15;
        __syncthreads();
        { int tl = tid_; asm volatile("" : "+v"(tl));
#pragma unroll
          for (int hh = 0; hh < 2; ++hh) { u32x4 v[4];
#pragma unroll
              for (int i = 0; i < 4; ++i) { const int idx = (hh * 4 + i) * 512 + tl, row = idx >> 3, c = idx & 7; v[i] = *(const u32x4*)((const unsigned char*)KC + (size_t)(b * 512 + row) * 2048 + h * 128 + c * 16); }
#pragma unroll
              for (int i = 0; i < 4; ++i) { const int idx = (hh * 4 + i) * 512 + tl, row = idx >> 3, c = idx & 7; *(LAS u32x4*)(lds + ATT_LK + row * 144 + c * 16) = v[i]; } }
#pragma unroll
          for (int hh = 0; hh < 2; ++hh) { u32x4 v[4];
#pragma unroll
              for (int i = 0; i < 4; ++i) { const int idx = (hh * 4 + i) * 512 + tl, row = idx >> 6, c = idx & 63; v[i] = *(const u32x4*)((const unsigned char*)VCT + (size_t)(b * DM + h * 64 + row) * 1024 + c * 16); }
#pragma unroll
              for (int i = 0; i < 4; ++i) { const int idx = (hh * 4 + i) * 512 + tl, row = idx >> 6, c = idx & 63; *(LAS u32x4*)(lds + ATT_LV + row * 1040 + c * 16) = v[i]; } } }
        __syncthreads();
        for (int rp2 = 0; rp2 < 2; ++rp2) {
            const int r = (sl * 2 + rp2) * 2 + (wave >> 2), cb = wave & 3; const int qtok = M_CTX + b * 2048 + r * 64 + cb * 16;
            const int row_start = min(max(r - 4, 0), 24), col_start = min(max(cb * 16 - 8, 0), 32);
            bf16x8 qf[2];
#pragma unroll
            for (int ks = 0; ks < 2; ++ks) qf[ks] = *(const bf16x8*)(Q + (size_t)(qtok + fr) * DM + h * 64 + ks * 32 + 8 * fq);
            f32x4 O[4];
#pragma unroll
            for (int d = 0; d < 4; ++d) O[d] = (f32x4){0.f, 0.f, 0.f, 0.f};
            float mrun = -INFINITY, lrun = 0.f; const int qc = cb * 16 + fr, qstart = min(max(qc - 8, 0), 48);
            const float* rpb = p->in[32] + (size_t)h * 15 * 31;
            for (int ch = 0; ch < 2; ++ch) { const int y0 = row_start + ch * 4; const size_t t0 = (size_t)M_CTX + b * 2048 + y0 * 64 + col_start;
                attn_chunk<1>(O, mrun, lrun, qf, fr, fq, lds, lds, 0, 0, Kn + t0 * DM, VT + t0, h, rpb, y0 - r + 7, col_start, qc, qstart); }
            for (int ch = 0; ch < 4; ++ch) attn_chunk<0>(O, mrun, lrun, qf, fr, fq, lds + ATT_LK, lds + ATT_LV, 1040, ch * 128, nullptr, nullptr, h, nullptr, 0, 0, 0, 0);
            attn_store(HB, O, lrun, qtok, h, fr, fq);
        }
    }
    for (int job = bid_; job < 512; job += G) {
        const int b = job >> 4, h = job & 15;
        __syncthreads();
        { int tl = tid_; asm volatile("" : "+v"(tl)); u32x4 v[4];
#pragma unroll
          for (int i = 0; i < 4; ++i) { const int idx = i * 512 + tl, row = idx >> 3, c = idx & 7; v[i] = *(const u32x4*)((const unsigned char*)Kn + (size_t)(b * 256 + row) * 2048 + h * 128 + c * 16); }
#pragma unroll
          for (int i = 0; i < 4; ++i) { const int idx = i * 512 + tl, row = idx >> 3, c = idx & 7; *(LAS u32x4*)(lds + ATT_LK + row * 144 + c * 16) = v[i]; }
#pragma unroll
          for (int i = 0; i < 4; ++i) { const int idx = i * 512 + tl, row = idx >> 5, c = idx & 31; v[i] = *(const u32x4*)((const unsigned char*)VT + ((size_t)(h * 64 + row) * M_TOK + b * 256) * 2 + c * 16); }
#pragma unroll
          for (int i = 0; i < 4; ++i) { const int idx = i * 512 + tl, row = idx >> 5, c = idx & 31; *(LAS u32x4*)(lds + ATT_LV + row * 528 + c * 16) = v[i]; } }
        __syncthreads();
        for (int q2 = 0; q2 < 2; ++q2) {
            const int qtok = b * 256 + (wave * 2 + q2) * 16;
            bf16x8 qf[2];
#pragma unroll
            for (int ks = 0; ks < 2; ++ks) qf[ks] = *(const bf16x8*)(Q + (size_t)(qtok + fr) * DM + h * 64 + ks * 32 + 8 * fq);
            f32x4 O[4];
#pragma unroll
            for (int d = 0; d < 4; ++d) O[d] = (f32x4){0.f, 0.f, 0.f, 0.f};
            float mrun = -INFINITY, lrun = 0.f;
            for (int ch = 0; ch < 2; ++ch) attn_chunk<0>(O, mrun, lrun, qf, fr, fq, lds + ATT_LK, lds + ATT_LV, 528, ch * 128, nullptr, nullptr, h, nullptr, 0, 0, 0, 0);
            attn_store(HB, O, lrun, qtok, h, fr, fq);
        }
    }
    __syncthreads();
}

#define XB_TMO      128
#define XB_XCNT(j)  (256  + 64 * (j))
#define XB_XSUB(j)  (1280 + 64 * (j))
#define XB_XGEN(j)  (2304 + 64 * (j))
#define XB_TOP      3328
#define XB_TOPGEN   3392
#define XCD_BAR_WORDS 3456
#define XB_SPIN_CAP (1u << 18)
DI unsigned xb_ld(unsigned* p)              { return __hip_atomic_load(p, __ATOMIC_RELAXED, __HIP_MEMORY_SCOPE_AGENT); }
DI unsigned xb_add(unsigned* p, unsigned v) { return __hip_atomic_fetch_add(p, v, __ATOMIC_RELAXED, __HIP_MEMORY_SCOPE_AGENT); }
DI unsigned xb_xcc_id() { return (unsigned)__builtin_amdgcn_s_getreg((3 << 11) | 20) & 0xFu; }
#define XB_SPIN(cond, bar) do { unsigned _sp = 0; while (cond) { __builtin_amdgcn_s_sleep(1); \
    if ((++_sp & 255u) == 0u) { if (xb_ld(&(bar)[XB_TMO])) break; if (_sp > XB_SPIN_CAP) { atomicAdd(&(bar)[XB_TMO], 1u); break; } } } } while (0)
DI void xcd_barrier_post(unsigned* bar, int tid) { if (tid == 0) (void)xb_add(&bar[XB_XCNT(xb_xcc_id())], 1u); }
DI void xcd_barrier_complete(unsigned* bar, unsigned x, unsigned& nloc, unsigned& nx) {
    const unsigned G = gridDim.x * gridDim.y * gridDim.z;
    unsigned sum, cnt, mine, sp = 0u;
    for (;;) {
        sum = 0u; cnt = 0u; mine = 0u;
#pragma unroll
        for (unsigned j = 0; j < 16; ++j) { const unsigned c = xb_ld(&bar[XB_XCNT(j)]); sum += c; cnt += (c > 0u) ? 1u : 0u; mine = (j == x) ? c : mine; }
        if (sum == G) break;
        __builtin_amdgcn_s_sleep(1);
        if ((++sp & 255u) == 0u) { if (xb_ld(&bar[XB_TMO])) break; if (sp > XB_SPIN_CAP) { atomicAdd(&bar[XB_TMO], 1u); break; } }
    }
    nloc = mine > 0u ? mine : 1u; nx = cnt > 0u ? cnt : 1u;
}
DI void xcd_barrier(unsigned* bar, volatile LAS unsigned* st, int tid) {
    asm volatile("s_waitcnt vmcnt(0)" ::: "memory");
    __syncthreads();
    if (tid == 0) {
        const unsigned x = xb_xcc_id();
        __builtin_amdgcn_s_waitcnt(0);
        unsigned nloc = st[0], nx = st[1];
        if (nloc == 0u) { xcd_barrier_complete(bar, x, nloc, nx); st[0] = nloc; st[1] = nx; }
        const unsigned old = xb_add(&bar[XB_XSUB(x)], 1u);
        const unsigned gen = old / nloc;
        if (old + 1u == (gen + 1u) * nloc) {
            __builtin_amdgcn_fence(__ATOMIC_RELEASE, "agent");
            asm volatile("s_waitcnt vmcnt(0)" ::: "memory");
            const unsigned og = xb_add(&bar[XB_TOP], 1u);
            const unsigned tg = og / nx;
            if (og + 1u == (tg + 1u) * nx) xb_add(&bar[XB_TOPGEN], 1u);
            else XB_SPIN(xb_ld(&bar[XB_TOPGEN]) == tg, bar);
            __builtin_amdgcn_fence(__ATOMIC_ACQUIRE, "agent");
            xb_add(&bar[XB_XGEN(x)], 1u);
            asm volatile("s_waitcnt vmcnt(0)" ::: "memory");
        } else {
            XB_SPIN(xb_ld(&bar[XB_XGEN(x)]) == gen, bar);
            __builtin_amdgcn_fence(__ATOMIC_ACQUIRE, "agent");
            asm volatile("s_waitcnt vmcnt(0)" ::: "memory");
        }
    }
    __syncthreads();
}

__global__ void __launch_bounds__(512, 2) fwd_megakernel(Params p_arg) {
    extern __shared__ __attribute__((aligned(16))) unsigned char lds_raw[];
    cg::grid_group grid = cg::this_grid();
    LAS unsigned char* lds = (LAS unsigned char*)lds_raw;
    const int wave0 = __builtin_amdgcn_readfirstlane(threadIdx.x >> 6); (void)p_arg;
    if (threadIdx.x < 4) ((LAS unsigned*)(lds + LDS_BARW))[threadIdx.x] = 0u;
    __syncthreads();
    xcd_barrier_post((unsigned*)p_arg.ws, (int)threadIdx.x);
    const int nsteps = NSTEPS < NSTEPS_RUN ? NSTEPS : NSTEPS_RUN;
    for (int st = 0; st < nsteps; ++st) {
        const int op = __builtin_amdgcn_readfirstlane(PROG[st][0]), arg = __builtin_amdgcn_readfirstlane(PROG[st][1]), sync = __builtin_amdgcn_readfirstlane(PROG[st][2]);
        int bid_ = blockIdx.x, wave = wave0; asm volatile("" : "+s"(bid_), "+s"(wave));
        KP p = (KP)__builtin_amdgcn_kernarg_segment_ptr(); asm volatile("" : "+s"(p));
        unsigned char* ws = p->ws;
        bool isgemm = false; pg8::GD g;
        g.sAz = 0; g.sBz = 0; g.sApn = 0; g.nZ = 1; g.perm = 1; g.G = gridDim.x; g.c = bid_; g.ws = ws; g.out = p->out; g.p0 = nullptr; g.p1 = nullptr; g.p2 = nullptr; g.p3 = nullptr; g.f0 = 1.f; g.i0 = 0; g.i1 = 0;
        g.A = (const char*)(ws + WS_HB); g.B = nullptr; g.lda = DM; g.ldb = DM; g.K = DM; g.nM = 48; g.nN = 4; g.mode = pg8::E_RES;
        const float* mods = (const float*)(ws + WS_MODS);
        switch (op) {

#ifndef SKIP_PRO
        case OP_PRO: prologue(p, lds, wave, bid_); break;
#endif


#ifndef SKIP_NORM
        case OP_NORM: norm_phase(p, arg >> 2, arg & 3, wave, bid_); break;
#endif


#ifndef SKIP_NORMT
        case OP_NORMT: normT_phase(p, lds, arg >> 2, arg & 3, wave, bid_); break;
#endif

        case OP_FFNUP: isgemm = true; g.B = (const char*)(ws + WS_W + (size_t)arg * FFN_BYTES); g.nN = 22; g.perm = 0; g.mode = pg8::E_FFNUP; break;
        case OP_FFNDN: isgemm = true; g.A = (const char*)(ws + WS_SCR); g.lda = LDG; g.B = (const char*)(ws + WS_W + (size_t)arg * FFN_BYTES + W13_BYTES); g.ldb = LDG; g.K = DFF; g.perm = 0;
            g.p0 = mods + (size_t)((arg >> 1) * 3) * 9216 + ((arg & 1) ? 8 : 2) * DM; g.f0 = 0.5f; if (arg == 0) { g.p2 = p->in[0]; g.p3 = p->in[1] - (size_t)M_CTX * DM; } break;
        case OP_MLQKV: isgemm = true; g.B = (const char*)(ws + WS_MLQ); g.nN = 16; g.mode = pg8::E_MLQKV; break;
        case OP_NAQKV: isgemm = true; g.B = (const char*)(ws + WS_NAQ); g.nN = 12; g.mode = pg8::E_NAQKV; break;
        case OP_MIXOUT: isgemm = true; g.perm = 0; g.p0 = mods + (size_t)(arg * 3) * 9216 + 5 * DM;
            g.B = (const char*)(ws + (arg == 0 ? WS_MLO : arg == 1 ? WS_FNO : arg == 2 ? WS_GMO : WS_NAO)); if (arg == 1) g.p1 = p->in[23]; break;
        case OP_F1L: isgemm = true; g.A = (const char*)(ws + WS_DS2048); g.lda = 2048; g.B = (const char*)(ws + WS_SCR + SCR_HT) + (size_t)M_CTX * 2; g.ldb = M_TOK; g.K = 2048; g.nM = 16; g.nN = 4; g.nZ = 2; g.sBz = 2048 * 2;
            g.mode = pg8::E_F1; g.i0 = 2048; g.i1 = M_CTX; g.G = gridDim.x / 2; g.c = bid_ < g.G ? bid_ : (1 << 28); break;
        case OP_F1C: isgemm = true; g.A = (const char*)(ws + WS_DS256); g.lda = 256; g.B = (const char*)(ws + WS_SCR + SCR_HT); g.ldb = M_TOK; g.K = 256; g.nM = 2; g.nN = 4; g.nZ = 32; g.sBz = 256 * 2;
            g.mode = pg8::E_F1; g.i0 = 256; g.i1 = 0; { const int G1 = gridDim.x / 2; g.G = gridDim.x - G1; g.c = bid_ >= G1 ? bid_ - G1 : (1 << 28); } break;
        case OP_F2: isgemm = true; g.A = (const char*)(ws + WS_SCR + SCR_Y); g.lda = 512; g.B = (const char*)(ws + WS_DC); g.ldb = 512; g.K = 512; g.nM = 192; g.nN = 1; g.mode = pg8::E_F2; break;
        case OP_GIN: isgemm = true; g.B = (const char*)(ws + WS_GMI); g.nN = 8; g.mode = pg8::E_GIN; g.p0 = p->in[25]; break;

#ifndef SKIP_GTR
        case OP_GTR: gtrans_phase(p, lds, wave, bid_); break;
#endif

        case OP_GSP: isgemm = true; g.A = (const char*)(ws + WS_ABLK); g.lda = 256; g.sApn = 256 * 256 * 2; g.B = (const char*)(ws + WS_SCR + SCR_VNT); g.ldb = M_TOK; g.K = 256; g.nM = 1; g.nN = 4; g.nZ = 48; g.sBz = 256 * 2;
            g.mode = pg8::E_SP; g.p0 = p->in[26]; g.p1 = p->in[28]; break;

#ifndef SKIP_ML1
        case OP_ML1: ml1_phase(p, lds, wave, bid_); break;
#endif


#ifndef SKIP_ML2
        case OP_ML2: ml2_phase(p, lds, wave, bid_); break;
#endif


#ifndef SKIP_ATT
        case OP_NAATT: attn_phase(p, lds, wave, bid_); break;
#endif


#ifndef SKIP_FIN
        case OP_FINAL: final_phase(p, wave, bid_); break;
#endif

        default: break;
        }

#ifndef SKIP_GEMM
        if (isgemm) pg8::gemm_phase(lds, g, wave);
#endif
#ifndef SKIP_BG
        if (isgemm) { const int lo1 = __builtin_amdgcn_readfirstlane(BGTAB[st][0]), hi1 = __builtin_amdgcn_readfirstlane(BGTAB[st][1]);
            if (hi1 > lo1) { const int nwg = g.nZ * g.nM * g.nN, Gg = gridDim.x, rounds = (nwg + Gg - 1) / Gg, first_idle = nwg - (rounds - 1) * Gg, nidle = Gg - first_idle;
                if (bid_ >= first_idle && nidle > 0) { const int lane = fresh_lane(); const int lo2 = __builtin_amdgcn_readfirstlane(BGTAB[st][2]), hi2 = __builtin_amdgcn_readfirstlane(BGTAB[st][3]);
                    const int rank = (bid_ - first_idle) * 8 + wave, nr = nidle * 8;
                    conv_range(p, lds, wave, lane, lo1, hi1, rank, nr); conv_range(p, lds, wave, lane, lo2, hi2, rank, nr); } } }
#endif

        if (sync) { if (p_arg.ws == nullptr) grid.sync();
            { int z2_ = 0; asm volatile("" : "+v"(z2_)); const int t0_ = wave0 * 64 + (int)__builtin_amdgcn_mbcnt_hi(~0u, __builtin_amdgcn_mbcnt_lo(~0u, z2_)); xcd_barrier((unsigned*)p_arg.ws, (volatile LAS unsigned*)(lds + LDS_BARW), t0_); } }
    }
}

extern "C" void kernel_launch(void* const* d_in, const int* in_sizes, int n_in, void* d_out, int out_size, void* d_ws, size_t ws_size, hipStream_t stream) {
    static int grid = 0;
    if (grid == 0) {
        if (n_in != 33 || ws_size < WS_END) { fprintf(stderr, "kernel_launch: unexpected n_in %d / ws_size %zu (need %zu)\n", n_in, ws_size, (size_t)WS_END); grid = -1; return; }
        int dev = 0, cus = 0, per_cu = 0;
        hipGetDevice(&dev); hipDeviceGetAttribute(&cus, hipDeviceAttributeMultiprocessorCount, dev);
        hipFuncSetAttribute((const void*)fwd_megakernel, hipFuncAttributeMaxDynamicSharedMemorySize, LDS_BYTES);
        hipOccupancyMaxActiveBlocksPerMultiprocessor(&per_cu, (const void*)fwd_megakernel, 512, LDS_BYTES);
        if (per_cu < 1) { fprintf(stderr, "kernel_launch: occupancy query says %d blocks per CU\n", per_cu); grid = -1; return; }
        grid = cus;
        fprintf(stderr, "kernel_launch: grid %d (per_cu %d), ws %zu\n", grid, per_cu, ws_size);
    }
    if (grid < 0) return;
    hipMemsetAsync(d_ws, 0, 2 * MiB, stream);
    Params p{};
    for (int i = 0; i < 33; ++i) p.in[i] = (const float*)d_in[i];
    p.out = (float*)d_out; p.ws = (unsigned char*)d_ws;
    void* args[] = {&p};
    hipError_t e = hipLaunchCooperativeKernel((const void*)fwd_megakernel, dim3(grid), dim3(512), args, LDS_BYTES, stream);
    if (e != hipSuccess) fprintf(stderr, "cooperative launch failed: %s (grid %d)\n", hipGetErrorString(e), grid);
}
```

```cpp
#include <hip/hip_runtime.h>
#include <hip/hip_cooperative_groups.h>
#include <cstdio>
#include <cstdint>
namespace cg = cooperative_groups;

#define DI __device__ __forceinline__
#define LAS __attribute__((address_space(3)))
typedef unsigned short bf16_t;
typedef short bf16x8 __attribute__((ext_vector_type(8)));
typedef float f32x4 __attribute__((ext_vector_type(4)));
typedef float f32x2 __attribute__((ext_vector_type(2)));
typedef unsigned u32x4 __attribute__((ext_vector_type(4)));
typedef unsigned u32x2 __attribute__((ext_vector_type(2)));
typedef __bf16 bf16x2_t __attribute__((ext_vector_type(2)));
#define GAS __attribute__((address_space(1)))
typedef const GAS char* gcp;
typedef GAS char* gwp;

#ifndef NSTEPS_RUN
#define NSTEPS_RUN 1000
#endif

constexpr int M_TOK = 12288, M_CTX = 8192, DM = 1024, DFF = 2816, LDG = 2816;
constexpr float EPSN = 1e-6f;
constexpr size_t O_C = 12582912, O_N = 29360128, O_M = 29425664, O_K = 29425920, O_V = 37814528;
constexpr size_t MiB = 1u << 20;
constexpr size_t WS_MODS = 1 * MiB, WS_IFG = 2 * MiB, WS_ABLK = 3 * MiB, WS_DS256 = 3 * MiB + 512 * 1024, WS_DC = 3 * MiB + 768 * 1024;
constexpr size_t WS_DS2048 = 4 * MiB, WS_KC = 20 * MiB, WS_VCT = 22 * MiB, WS_MLST = 24 * MiB, WS_W = 26 * MiB;
constexpr size_t W13_BYTES = (size_t)5632 * 1024 * 2, W2_BYTES = (size_t)1024 * LDG * 2, FFN_BYTES = W13_BYTES + W2_BYTES;
constexpr size_t WS_MLQ = WS_W + 8 * FFN_BYTES, WS_MLO = WS_MLQ + 8 * MiB, WS_FNO = WS_MLO + 2 * MiB, WS_GMI = WS_FNO + 2 * MiB,
                 WS_GMO = WS_GMI + 4 * MiB, WS_NAQ = WS_GMO + 2 * MiB, WS_NAO = WS_NAQ + 6 * MiB, WS_HB = WS_NAO + 2 * MiB;
constexpr size_t WS_SCR = WS_HB + 24 * MiB;
constexpr size_t SCR_Q = 0, SCR_K = 24 * MiB, SCR_KT = 48 * MiB, SCR_VT = 72 * MiB, SCR_OG = 96 * MiB, SCR_SNAP = 120 * MiB;
constexpr size_t SCR_HT = 0, SCR_Y = 24 * MiB, SCR_U = 0, SCR_V = 24 * MiB, SCR_VNT = 48 * MiB;
constexpr size_t WS_END = WS_SCR + 184 * MiB;
static_assert(WS_HB % 4096 == 0 && FFN_BYTES % 256 == 0, "ws map");
constexpr int MLST_STRIDE = 272;

constexpr int LDS_BYTES = 153600 + 64, LDS_BARW = 153600;

enum { OP_PRO = 0, OP_NORM, OP_NORMT, OP_FFNUP, OP_FFNDN, OP_MLQKV, OP_ML1, OP_ML2, OP_MIXOUT, OP_F1L, OP_F1C, OP_F2, OP_GIN, OP_GTR, OP_GSP, OP_NAQKV, OP_NAATT, OP_FINAL };
__constant__ unsigned char PROG[][3] = {
    {OP_PRO, 0, 1},
    {OP_NORM, 0, 1}, {OP_FFNUP, 0, 1}, {OP_FFNDN, 0, 1}, {OP_NORM, 1, 1}, {OP_MLQKV, 0, 1}, {OP_ML1, 0, 1}, {OP_ML2, 0, 1}, {OP_MIXOUT, 0, 1}, {OP_NORM, 2, 1}, {OP_FFNUP, 1, 1}, {OP_FFNDN, 1, 1},
    {OP_NORM, 4, 1}, {OP_FFNUP, 2, 1}, {OP_FFNDN, 2, 1}, {OP_NORMT, 5, 1}, {OP_F1L, 0, 0}, {OP_F1C, 0, 1}, {OP_F2, 0, 1}, {OP_MIXOUT, 1, 1}, {OP_NORM, 6, 1}, {OP_FFNUP, 3, 1}, {OP_FFNDN, 3, 1},
    {OP_NORM, 8, 1}, {OP_FFNUP, 4, 1}, {OP_FFNDN, 4, 1}, {OP_NORM, 9, 1}, {OP_GIN, 0, 1}, {OP_GTR, 0, 1}, {OP_GSP, 0, 1}, {OP_MIXOUT, 2, 1}, {OP_NORM, 10, 1}, {OP_FFNUP, 5, 1}, {OP_FFNDN, 5, 1},
    {OP_NORM, 12, 1}, {OP_FFNUP, 6, 1}, {OP_FFNDN, 6, 1}, {OP_NORM, 13, 1}, {OP_NAQKV, 0, 1}, {OP_NAATT, 0, 1}, {OP_MIXOUT, 3, 1}, {OP_NORM, 14, 1}, {OP_FFNUP, 7, 1}, {OP_FFNDN, 7, 1},
    {OP_FINAL, 0, 0}};
constexpr int NSTEPS = sizeof(PROG) / 3;
__constant__ int BGTAB[][4] = {
    {0,0,0,0},
    {0,0,0,0}, {4224,8448,0,0}, {8448,12672,0,0}, {0,0,0,0}, {0,0,0,0}, {0,0,0,0}, {0,0,0,0}, {0,0,0,0}, {0,0,0,0}, {12672,16896,33792+2560,33792+3072}, {16896,21120,0,0},
    {0,0,0,0}, {21120,25344,33792+3072,33792+4608}, {25344,29568,0,0}, {0,0,0,0}, {0,0,0,0}, {0,0,0,0}, {0,0,0,0}, {0,0,0,0}, {0,0,0,0}, {29568,33792,33792+4608,33792+6656}, {0,0,0,0},
    {0,0,0,0}, {0,0,0,0}, {0,0,0,0}, {0,0,0,0}, {0,0,0,0}, {0,0,0,0}, {0,0,0,0}, {0,0,0,0}, {0,0,0,0}, {0,0,0,0}, {0,0,0,0},
    {0,0,0,0}, {0,0,0,0}, {0,0,0,0}, {0,0,0,0}, {0,0,0,0}, {0,0,0,0}, {0,0,0,0}, {0,0,0,0}, {0,0,0,0}, {0,0,0,0},
    {0,0,0,0}};
static_assert(sizeof(BGTAB) / 16 == NSTEPS, "BGTAB rows");

struct Params { const float* in[33]; float* out; unsigned char* ws; };
typedef const __attribute__((address_space(4))) Params* KP;

DI unsigned pk2(float lo, float hi) { f32x2 v = {lo, hi}; bf16x2_t b = __builtin_convertvector(v, bf16x2_t); return __builtin_bit_cast(unsigned, b); }
DI float bflo(unsigned u) { return __uint_as_float(u << 16); }
DI float bfhi(unsigned u) { return __uint_as_float(u & 0xffff0000u); }
DI float bperm(int src_lane, float v) { return __int_as_float(__builtin_amdgcn_ds_bpermute(src_lane << 2, __float_as_int(v))); }
DI float shx(float v, int mask, int lane) { return bperm(lane ^ mask, v); }
DI float wave_sum(float v, int lane) {
#pragma unroll
    for (int o = 1; o < 64; o <<= 1) v += shx(v, o, lane);
    return v;
}
DI float wave_max(float v, int lane) {
#pragma unroll
    for (int o = 1; o < 64; o <<= 1) v = fmaxf(v, shx(v, o, lane));
    return v;
}
DI float fsigmoid(float x) { return __builtin_amdgcn_rcpf(1.0f + __expf(-x)); }
DI float fsilu(float x) { return x * fsigmoid(x); }
DI float fgelu_tanh(float x) { const float u = 1.5957691216f * (x + 0.044715f * x * x * x); return x * fsigmoid(u); }
DI float logsigmoidf(float x) { return fminf(x, 0.f) - __logf(1.0f + __expf(-fabsf(x))); }
DI bf16x8 ldf16(const void* ub, unsigned vo) { return *(const bf16x8*)((const char*)ub + vo); }
DI u32x2 ldf8(const void* ub, unsigned vo) { return *(const u32x2*)((const char*)ub + vo); }
#define MFMA16(a, b, c) __builtin_amdgcn_mfma_f32_16x16x32_bf16((a), (b), (c), 0, 0, 0)

DI int fresh_lane() { int z = 0; asm volatile("" : "+v"(z)); return (int)__builtin_amdgcn_mbcnt_hi(~0u, __builtin_amdgcn_mbcnt_lo(~0u, z)); }
namespace pg8 {
constexpr int BM = 256, BK = 64, HALF = 128, HTB = HALF * BK * 2, STAGE_BYTES = 8 * HTB;
DI int lds_byte(int r, int c) { const int st = (r >> 4) * 2 + (c >> 5), rr = r & 15, cc = c & 31, ob = rr * 64 + cc * 2; return st * 1024 + (ob ^ (((ob >> 9) & 1) << 5)); }
DI void stage_rc(int b, int& R, int& C) { const int st = b / 1024, sb = b % 1024, swz = sb ^ (((sb >> 9) & 1) << 5); R = (st >> 1) * 16 + swz / 64; C = (st & 1) * 32 + (swz % 64) / 2; }
DI int perm32(int rho) { const int n = rho >> 4, i = rho & 15; return 8 * (i >> 2) + 4 * n + (i & 3); }

struct Unit { const char* A; const char* B; int pm, pn, z; };
enum { E_FFNUP = 0, E_RES, E_MLQKV, E_NAQKV, E_F1, E_F2, E_GIN, E_SP };
struct GD {
    const char* A; const char* B; int lda, ldb, K, nM, nN, nZ; long sAz, sBz, sApn; int perm, mode;
    int G, c;
    unsigned char* ws; float* out; const float* p0; const float* p1; const float* p2; const float* p3; float f0; int i0, i1;
};
DI bool gd_next(const GD& g, int i, Unit& u) {
    const long L = (long)i * g.G + g.c; const int nwg = g.nZ * g.nM * g.nN; if (L >= nwg) return false;
    int wgid = (int)L; { const int q = nwg / 8, r = nwg % 8, xcd = wgid % 8, off = wgid / 8; wgid = (xcd < r ? xcd * (q + 1) : r * (q + 1) + (xcd - r) * q) + off; }
    const int per = g.nM * g.nN, z = wgid / per, w = wgid - z * per;
    const int nig = 6 * g.nN, gid = w / nig, fm = gid * 6, gsz = (g.nM - fm) < 6 ? (g.nM - fm) : 6;
    u.pm = fm + ((w % nig) % gsz); u.pn = (w % nig) / gsz; u.z = z;
    u.A = g.A + (long)z * g.sAz + (long)u.pm * 256 * g.lda * 2 + (long)u.pn * g.sApn;
    u.B = g.B + (long)z * g.sBz + (long)u.pn * 256 * g.ldb * 2;
    return true;
}

DI void store_T8(bf16_t* T, int c0, int row, int fr, const f32x4& v0, const f32x4& v1) {
    const unsigned o0 = pk2(v0[0], v0[1]), o1 = pk2(v0[2], v0[3]), o2 = pk2(v1[0], v1[1]), o3 = pk2(v1[2], v1[3]);
    const bool odd = fr & 1;
    const unsigned s0 = odd ? o0 : o2, s1 = odd ? o1 : o3;
    const unsigned r0 = (unsigned)__builtin_amdgcn_mov_dpp((int)s0, 0xB1, 0xF, 0xF, true), r1 = (unsigned)__builtin_amdgcn_mov_dpp((int)s1, 0xB1, 0xF, 0xF, true);
    const unsigned A0 = odd ? r0 : o0, A1 = odd ? r1 : o1, B0 = odd ? o2 : r0, B1 = odd ? o3 : r1;
    unsigned* d = (unsigned*)(T + (size_t)(c0 + (odd ? 4 : 0)) * M_TOK + (row & ~1));
    d[0] = (A0 & 0xffffu) | (B0 << 16); d[M_TOK / 2] = (A0 >> 16) | (B0 & 0xffff0000u); d[M_TOK] = (A1 & 0xffffu) | (B1 << 16); d[3 * (M_TOK / 2)] = (A1 >> 16) | (B1 & 0xffff0000u);
}
DI void epilogue(const GD& g, const f32x4 (&acc)[2][2][4][2], const Unit& u, int wr, int wc, int fr, int fq) {
    asm volatile("" : "+v"(fr), "+v"(fq));
    unsigned char* ws = g.ws;
    const int rowb = u.pm * 256 + wr * 64 + fr;
    if (g.mode == E_FFNUP) {
        bf16_t* G = (bf16_t*)(ws + WS_SCR);
        const int oc = (u.pn * 8 + (fq & 1) * 4 + wc) * 16 + (fq >> 1) * 8;
#pragma unroll
        for (int ai = 0; ai < 2; ++ai)
#pragma unroll
            for (int m = 0; m < 4; ++m) { const int row = rowb + ai * 128 + m * 16;
                const f32x4 a0 = acc[ai][0][m][0], b0 = acc[ai][0][m][1], a1 = acc[ai][1][m][0], b1 = acc[ai][1][m][1];
                unsigned A0 = pk2(fsilu(a0[0]) * b0[0], fsilu(a0[1]) * b0[1]), A1 = pk2(fsilu(a0[2]) * b0[2], fsilu(a0[3]) * b0[3]);
                unsigned B0 = pk2(fsilu(a1[0]) * b1[0], fsilu(a1[1]) * b1[1]), B1 = pk2(fsilu(a1[2]) * b1[2], fsilu(a1[3]) * b1[3]);
                { auto r0 = __builtin_amdgcn_permlane16_swap(A0, B0, false, false); A0 = r0[0]; B0 = r0[1]; auto r1 = __builtin_amdgcn_permlane16_swap(A1, B1, false, false); A1 = r1[0]; B1 = r1[1]; }
                u32x4 w; w.x = A0; w.y = A1; w.z = B0; w.w = B1;
                *(u32x4*)(G + (size_t)row * LDG + oc) = w; }
    } else if (g.mode == E_RES) {
        const int row0 = u.pm * 256; const int cond = row0 < M_CTX ? 0 : 1 + ((row0 - M_CTX) >> 11);
        const float* gate = g.p0 + cond * 9216; float* X = g.out; const float* Xr = g.p2 ? (row0 < M_CTX ? g.p2 : g.p3) : (const float*)g.out;
        f32x4 xv[2][4], gq[2], bq[2];
#define RES_COL(q) (u.pn * 256 + ((q) >> 1) * 128 + wc * 32 + 16 * ((q) & 1) + 4 * fq)
#define RES_GB(q) do { const int col_ = RES_COL(q); gq[(q) & 1] = *(const f32x4*)(gate + col_) * g.f0; bq[(q) & 1] = g.p1 ? *(const f32x4*)(g.p1 + col_) : (f32x4){0.f, 0.f, 0.f, 0.f}; } while (0)
#define RES_LOAD(t) do { const int col_ = RES_COL((t) >> 1); \
        _Pragma("unroll") for (int i_ = 0; i_ < 4; ++i_) xv[(t) & 1][i_] = *(const f32x4*)(Xr + (size_t)(rowb + ((t) & 1) * 128 + i_ * 16) * DM + col_); } while (0)
        RES_GB(0); RES_LOAD(0);
#pragma unroll
        for (int t = 0; t < 8; ++t) { const int q = t >> 1, ai = t & 1;
            if (t < 7) { if (((t + 1) & 1) == 0) RES_GB((t + 1) >> 1); RES_LOAD(t + 1); }
            const int col = RES_COL(q);
#pragma unroll
            for (int i = 0; i < 4; ++i) { const f32x4 r = xv[t & 1][i] + gq[q & 1] * (acc[ai][q >> 1][i][q & 1] + bq[q & 1]); *(f32x4*)(X + (size_t)(rowb + ai * 128 + i * 16) * DM + col) = r; } }
#undef RES_GB
#undef RES_COL
#undef RES_LOAD
    } else if (g.mode == E_MLQKV || g.mode == E_NAQKV) {
        const bool na = g.mode == E_NAQKV; const int sect = u.pn >> 2;
        bf16_t* Q = (bf16_t*)(ws + WS_SCR + SCR_Q); bf16_t* Kn = (bf16_t*)(ws + WS_SCR + SCR_K); bf16_t* KT = (bf16_t*)(ws + WS_SCR + SCR_KT);
        bf16_t* VT = (bf16_t*)(ws + WS_SCR + SCR_VT); bf16_t* OG = (bf16_t*)(ws + WS_SCR + SCR_OG);
#pragma unroll
        for (int ai = 0; ai < 2; ++ai)
#pragma unroll
            for (int m = 0; m < 4; ++m) { const int row = rowb + ai * 128 + m * 16;
#pragma unroll
                for (int bj = 0; bj < 2; ++bj) { const int c0 = (u.pn & 3) * 256 + bj * 128 + wc * 32 + 8 * fq; f32x4 v0 = acc[ai][bj][m][0], v1 = acc[ai][bj][m][1];
                    if (sect == 0) { const float s = na ? 0.125f : 1.0f; v0 *= s; v1 *= s; u32x4 w; w.x = pk2(v0[0], v0[1]); w.y = pk2(v0[2], v0[3]); w.z = pk2(v1[0], v1[1]); w.w = pk2(v1[2], v1[3]); *(u32x4*)(Q + (size_t)row * DM + c0) = w; }
                    else if (sect == 1) {
                        if (na) { if (row < M_CTX) { float* o = g.out + O_K + (size_t)row * DM + c0; *(f32x4*)o = v0; *(f32x4*)(o + 4) = v1; } }
                        else { v0 *= 0.0625f; v1 *= 0.0625f; }
                        u32x4 w; w.x = pk2(v0[0], v0[1]); w.y = pk2(v0[2], v0[3]); w.z = pk2(v1[0], v1[1]); w.w = pk2(v1[2], v1[3]); *(u32x4*)(Kn + (size_t)row * DM + c0) = w;
                        if (!na) store_T8(KT, c0, row, fr, v0, v1);
                    } else if (sect == 2) {
                        if (na && row < M_CTX) { float* o = g.out + O_V + (size_t)row * DM + c0; *(f32x4*)o = v0; *(f32x4*)(o + 4) = v1; }
                        store_T8(VT, c0, row, fr, v0, v1);
                    } else { u32x4 w; w.x = pk2(fsigmoid(v0[0]), fsigmoid(v0[1])); w.y = pk2(fsigmoid(v0[2]), fsigmoid(v0[3])); w.z = pk2(fsigmoid(v1[0]), fsigmoid(v1[1])); w.w = pk2(fsigmoid(v1[2]), fsigmoid(v1[3])); *(u32x4*)(OG + (size_t)row * DM + c0) = w; }
                } }
    } else if (g.mode == E_F1) {
        bf16_t* Y = (bf16_t*)(ws + WS_SCR + SCR_Y); const int S = g.i0, tok0 = g.i1 + u.z * S;
#pragma unroll
        for (int ai = 0; ai < 2; ++ai)
#pragma unroll
            for (int m = 0; m < 4; ++m) { const int r = rowb + ai * 128 + m * 16; const int cs = r >= S ? 1 : 0, sp = r - cs * S;
#pragma unroll
                for (int bj = 0; bj < 2; ++bj) { const int col = u.pn * 256 + bj * 128 + wc * 32 + 8 * fq, gi = col >> 8, c = col & 255; const f32x4 v0 = acc[ai][bj][m][0], v1 = acc[ai][bj][m][1];
                    u32x4 w; w.x = pk2(v0[0], v0[1]); w.y = pk2(v0[2], v0[3]); w.z = pk2(v1[0], v1[1]); w.w = pk2(v1[2], v1[3]);
                    *(u32x4*)(Y + ((size_t)(tok0 + sp) * 4 + gi) * 512 + cs * 256 + c) = w; } }
    } else if (g.mode == E_F2) {
        bf16_t* HB = (bf16_t*)(ws + WS_HB);
        const float sc = (u.pm * 64 < M_CTX) ? (1.0f / 256.0f) : 0.0013810679f;
#pragma unroll
        for (int ai = 0; ai < 2; ++ai)
#pragma unroll
            for (int m = 0; m < 4; ++m) { const int row = rowb + ai * 128 + m * 16;
#pragma unroll
                for (int bj = 0; bj < 2; ++bj) { const int col = bj * 128 + wc * 32 + 8 * fq; const f32x4 v0 = acc[ai][bj][m][0] * sc, v1 = acc[ai][bj][m][1] * sc;
                    u32x4 w; w.x = pk2(v0[0], v0[1]); w.y = pk2(v0[2], v0[3]); w.z = pk2(v1[0], v1[1]); w.w = pk2(v1[2], v1[3]);
                    *(u32x4*)(HB + (size_t)row * 256 + col) = w; } }
    } else if (g.mode == E_GIN) {
        bf16_t* U = (bf16_t*)(ws + WS_SCR + SCR_U); bf16_t* V = (bf16_t*)(ws + WS_SCR + SCR_V);
#pragma unroll
        for (int bj = 0; bj < 2; ++bj) { const int col = u.pn * 256 + bj * 128 + wc * 32 + 8 * fq; const f32x4 b0 = *(const f32x4*)(g.p0 + col), b1 = *(const f32x4*)(g.p0 + col + 4);
            bf16_t* dst = col < 1024 ? U + col : V + (col - 1024);
#pragma unroll
            for (int ai = 0; ai < 2; ++ai)
#pragma unroll
                for (int m = 0; m < 4; ++m) { const int row = rowb + ai * 128 + m * 16; const f32x4 v0 = acc[ai][bj][m][0] + b0, v1 = acc[ai][bj][m][1] + b1;
                    u32x4 w; w.x = pk2(fgelu_tanh(v0[0]), fgelu_tanh(v0[1])); w.y = pk2(fgelu_tanh(v0[2]), fgelu_tanh(v0[3])); w.z = pk2(fgelu_tanh(v1[0]), fgelu_tanh(v1[1])); w.w = pk2(fgelu_tanh(v1[2]), fgelu_tanh(v1[3]));
                    *(u32x4*)(dst + (size_t)row * DM) = w; } }
    } else {
        bf16_t* HB = (bf16_t*)(ws + WS_HB); const bf16_t* U = (const bf16_t*)(ws + WS_SCR + SCR_U);
        const int rb = u.z * 256 + wr * 64 + fr;
#pragma unroll
        for (int bj = 0; bj < 2; ++bj) { const int col = u.pn * 256 + bj * 128 + wc * 32 + 8 * fq; const f32x4 g0 = *(const f32x4*)(g.p0 + col), g1 = *(const f32x4*)(g.p0 + col + 4);
            u32x4 uv[2][4];
#pragma unroll
            for (int ai = 0; ai < 2; ++ai)
#pragma unroll
                for (int m = 0; m < 4; ++m) uv[ai][m] = *(const u32x4*)(U + (size_t)(rb + ai * 128 + m * 16) * DM + col);
            asm volatile("" ::: "memory");
#pragma unroll
            for (int ai = 0; ai < 2; ++ai)
#pragma unroll
                for (int m = 0; m < 4; ++m) { const int row = rb + ai * 128 + m * 16; const float bs = g.p1[u.pn * 128 + (row & 127)];
                    const u32x4 uu = uv[ai][m]; const f32x4 a0 = acc[ai][bj][m][0] * g0 + bs, a1 = acc[ai][bj][m][1] * g1 + bs;
                    u32x4 w; w.x = pk2(bflo(uu.x) * a0[0], bfhi(uu.x) * a0[1]); w.y = pk2(bflo(uu.y) * a0[2], bfhi(uu.y) * a0[3]); w.z = pk2(bflo(uu.z) * a1[0], bfhi(uu.z) * a1[1]); w.w = pk2(bflo(uu.w) * a1[2], bfhi(uu.w) * a1[3]);
                    *(u32x4*)(HB + (size_t)row * DM + col) = w; } }
    }
}

DI void gemm_phase(LAS unsigned char* lds, const GD& g, int wave_) {
    const int tid_ = wave_ * 64 + fresh_lane();
    const int tid = tid_, wid = __builtin_amdgcn_readfirstlane(tid >> 6), lane = tid & 63, wr = wid >> 2, wc = wid & 3, fr = lane & 15, fq = lane >> 4;
    const int K = g.K, nt = K / BK;
    unsigned voffA[2], voffB[2];
#pragma unroll
    for (int i = 0; i < 2; ++i) { int R, C; stage_rc(tid * 16 + i * 8192, R, C); const int Rb = g.perm ? ((R & ~31) + perm32(R & 31)) : R;
        voffA[i] = (unsigned)(R * g.lda + C) * 2u; voffB[i] = (unsigned)(Rb * g.ldb + C) * 2u; }
    const size_t kstep = (size_t)(BK * 2);
    const size_t hstepA = (size_t)HALF * g.lda * 2, hstepB = (size_t)HALF * g.ldb * 2;
    const unsigned ldsw = (unsigned)wid * 1024u;
    const int aoff = lds_byte(wr * 64 + fr, fq * 8), boff = lds_byte(wc * 32 + fr, fq * 8);
#define PG8_SA(b, h) (((b) * 2 + (h)) * HTB)
#define PG8_SB(b, h) ((4 + (b) * 2 + (h)) * HTB)
#define PG8_STAGE(bufoff, gbase, voff) do { _Pragma("unroll") for (int _i = 0; _i < 2; ++_i) \
        __builtin_amdgcn_global_load_lds((const unsigned*)((const char*)(gbase) + (voff)[_i]), (LAS unsigned*)(lds + (bufoff) + ldsw + _i * 8192), 16, 0, 0); } while (0)
#define PG8_LDA(dst, b, h) do { _Pragma("unroll") for (int m = 0; m < 4; ++m) _Pragma("unroll") for (int k = 0; k < 2; ++k) dst[m][k] = *(const LAS bf16x8*)(lds + PG8_SA(b, h) + aoff + m * 2048 + k * 1024); } while (0)
#define PG8_LDB(dst, b, h) do { _Pragma("unroll") for (int n = 0; n < 2; ++n) _Pragma("unroll") for (int k = 0; k < 2; ++k) dst[n][k] = *(const LAS bf16x8*)(lds + PG8_SB(b, h) + boff + n * 2048 + k * 1024); } while (0)
#define PG8_MMA(ai, bj, At, Bt) do { __builtin_amdgcn_s_setprio(1); _Pragma("unroll") for (int m = 0; m < 4; ++m) _Pragma("unroll") for (int n = 0; n < 2; ++n) _Pragma("unroll") for (int k = 0; k < 2; ++k) \
        acc[ai][bj][m][n] = __builtin_amdgcn_mfma_f32_16x16x32_bf16(Bt[n][k], At[m][k], acc[ai][bj][m][n], 0, 0, 0); __builtin_amdgcn_s_setprio(0); } while (0)
#define PG8_WAIT_V(n) asm volatile("s_waitcnt vmcnt(" #n ")" ::: "memory")
#define PG8_WAIT_L(n) asm volatile("s_waitcnt lgkmcnt(" #n ")" ::: "memory")
#define PG8_BAR __builtin_amdgcn_s_barrier()
#define PG8_SCHED __builtin_amdgcn_sched_barrier(0)
    Unit cur, nxt; int ui = 0;
    if (!gd_next(g, 0, cur)) return;
    f32x4 acc[2][2][4][2];
#pragma unroll
    for (int a = 0; a < 2; ++a)
#pragma unroll
        for (int b = 0; b < 2; ++b)
#pragma unroll
            for (int m = 0; m < 4; ++m)
#pragma unroll
                for (int n = 0; n < 2; ++n) acc[a][b][m][n] = (f32x4){0.f, 0.f, 0.f, 0.f};
    bf16x8 At[4][2], B0[2][2], B1[2][2];
    const char* cA = cur.A; const char* cB = cur.B;
    PG8_STAGE(PG8_SB(0, 0), cB, voffB); PG8_STAGE(PG8_SB(0, 1), cB + hstepB, voffB); PG8_STAGE(PG8_SA(0, 0), cA, voffA); PG8_STAGE(PG8_SA(0, 1), cA + hstepA, voffA);
    if (wr == 1) PG8_BAR;
    PG8_WAIT_V(2); PG8_BAR;
    PG8_STAGE(PG8_SB(1, 0), cB + kstep, voffB); PG8_STAGE(PG8_SA(1, 0), cA + kstep, voffA); PG8_STAGE(PG8_SB(1, 1), cB + hstepB + kstep, voffB);
    PG8_WAIT_V(6); PG8_BAR;
    for (;;) {
        const bool has_next = gd_next(g, ui + 1, nxt);
        const char* nA = has_next ? nxt.A : cA; const char* nB = has_next ? nxt.B : cB;
        for (int t = 0; t < nt; t += 2) {
            const bool last = (t == nt - 2);
            const char* a1 = cA + (size_t)(t + 1) * kstep;
            const char* a2 = last ? nA : cA + (size_t)(t + 2) * kstep; const char* b2 = last ? nB : cB + (size_t)(t + 2) * kstep;
            const char* a3 = a2 + kstep; const char* b3 = b2 + kstep;
            PG8_LDB(B0, 0, 0); PG8_LDB(B1, 0, 1); PG8_SCHED; PG8_LDA(At, 0, 0); PG8_STAGE(PG8_SA(1, 1), a1 + hstepA, voffA);
            PG8_WAIT_V(8); PG8_WAIT_L(0); PG8_BAR; PG8_MMA(0, 0, At, B0); PG8_MMA(0, 1, At, B1); PG8_BAR; PG8_SCHED;
            PG8_LDA(At, 0, 1); PG8_STAGE(PG8_SB(0, 0), b2, voffB); PG8_STAGE(PG8_SB(0, 1), b2 + hstepB, voffB); PG8_STAGE(PG8_SA(0, 0), a2, voffA);
            PG8_WAIT_V(8); PG8_WAIT_L(0); PG8_BAR; PG8_MMA(1, 0, At, B0); PG8_MMA(1, 1, At, B1); PG8_BAR; PG8_SCHED;
            PG8_LDB(B0, 1, 0); PG8_LDB(B1, 1, 1); PG8_SCHED; PG8_LDA(At, 1, 0); PG8_STAGE(PG8_SA(0, 1), a2 + hstepA, voffA);
            PG8_WAIT_V(8); PG8_WAIT_L(0); PG8_BAR; PG8_MMA(0, 0, At, B0); PG8_MMA(0, 1, At, B1); PG8_BAR; PG8_SCHED;
            PG8_LDA(At, 1, 1); PG8_STAGE(PG8_SB(1, 0), b3, voffB); PG8_STAGE(PG8_SB(1, 1), b3 + hstepB, voffB); PG8_STAGE(PG8_SA(1, 0), a3, voffA);
            PG8_WAIT_V(8); PG8_WAIT_L(0); PG8_BAR; PG8_MMA(1, 0, At, B0); PG8_MMA(1, 1, At, B1); PG8_BAR; PG8_SCHED;
        }
        if (wr == 0) PG8_BAR;
        epilogue(g, acc, cur, wr, wc, fr, fq);
        if (!has_next) break;
#pragma unroll
        for (int a = 0; a < 2; ++a)
#pragma unroll
            for (int b = 0; b < 2; ++b)
#pragma unroll
                for (int m = 0; m < 4; ++m)
#pragma unroll
                    for (int n = 0; n < 2; ++n) acc[a][b][m][n] = (f32x4){0.f, 0.f, 0.f, 0.f};
        cur = nxt; cA = nA; cB = nB; ++ui;
        if (wr == 1) PG8_BAR;
    }
    PG8_WAIT_V(0);
    PG8_BAR;
#undef PG8_SA
#undef PG8_SB
#undef PG8_STAGE
#undef PG8_LDA
#undef PG8_LDB
#undef PG8_MMA
#undef PG8_WAIT_V
#undef PG8_WAIT_L
#undef PG8_BAR
#undef PG8_SCHED
}
}

DI void tr_item(const float* W, int K, int N, bf16_t* WT, int mode, LAS float* scr, int item, int lane, int ldo = 0) {
    if (ldo == 0) ldo = K;
    const int nblk = N / 32, kb = item / nblk, nb = item % nblk, k0 = 64 * kb, n0 = 32 * nb;
    { f32x4 v[8];
#pragma unroll
      for (int i = 0; i < 8; ++i) v[i] = __builtin_nontemporal_load((const f32x4*)(W + (size_t)(k0 + i * 8 + (lane >> 3)) * N + n0 + 4 * (lane & 7)));
#pragma unroll
      for (int i = 0; i < 8; ++i) { LAS float* d = scr + (i * 8 + (lane >> 3)) * 33 + 4 * (lane & 7); d[0] = v[i][0]; d[1] = v[i][1]; d[2] = v[i][2]; d[3] = v[i][3]; } }
    asm volatile("s_waitcnt lgkmcnt(0)" ::: "memory");
    const int c = lane & 7;
#pragma unroll
    for (int j = 0; j < 4; ++j) { const int n = (lane >> 3) + 8 * j; const LAS float* s = scr + (8 * c) * 33 + n; const int ng = n0 + n;
        const int drow = mode == 0 ? ng : ((ng >> 4) * 32 + (ng & 15) + (mode == 2 ? 16 : 0));
        u32x4 o; o.x = pk2(s[0 * 33], s[1 * 33]); o.y = pk2(s[2 * 33], s[3 * 33]); o.z = pk2(s[4 * 33], s[5 * 33]); o.w = pk2(s[6 * 33], s[7 * 33]);
        *(u32x4*)(WT + (size_t)drow * ldo + k0 + 8 * c) = o; }
    asm volatile("s_waitcnt lgkmcnt(0)" ::: "memory");
}

DI void conv_item(KP p, LAS float* scr, int it, int lane) {
    unsigned char* ws = p->ws;
    constexpr int I_F = 1408, I_FFN = 3 * I_F * 8, I_MLQ = 16 * 96, I_SQ = 16 * 32, I_GMI = 16 * 64, I_VC = 8 * 32;
    int r = it;
    if (r < I_FFN) { const int lf = r / (3 * I_F), q = r % (3 * I_F), which = q / I_F, rr = q % I_F; bf16_t* d = (bf16_t*)(ws + WS_W + lf * FFN_BYTES);
        if (which == 0) tr_item(p->in[13] + (size_t)lf * DM * DFF, DM, DFF, d, 1, scr, rr, lane);
        else if (which == 1) tr_item(p->in[14] + (size_t)lf * DM * DFF, DM, DFF, d, 2, scr, rr, lane);
        else tr_item(p->in[15] + (size_t)lf * DM * DFF, DFF, DM, (bf16_t*)((unsigned char*)d + W13_BYTES), 0, scr, rr, lane, LDG);
        return; } r -= I_FFN;
    if (r < I_MLQ) { tr_item(p->in[16], DM, 3072, (bf16_t*)(ws + WS_MLQ), 0, scr, r, lane); return; } r -= I_MLQ;
    if (r < I_SQ) { tr_item(p->in[19], DM, DM, (bf16_t*)(ws + WS_MLQ) + (size_t)3072 * DM, 0, scr, r, lane); return; } r -= I_SQ;
    if (r < I_SQ) { tr_item(p->in[21], DM, DM, (bf16_t*)(ws + WS_MLO), 0, scr, r, lane); return; } r -= I_SQ;
    if (r < I_SQ) { tr_item(p->in[22], DM, DM, (bf16_t*)(ws + WS_FNO), 0, scr, r, lane); return; } r -= I_SQ;
    if (r < I_GMI) { tr_item(p->in[24], DM, 2048, (bf16_t*)(ws + WS_GMI), 0, scr, r, lane); return; } r -= I_GMI;
    if (r < I_SQ) { tr_item(p->in[29], DM, DM, (bf16_t*)(ws + WS_GMO), 0, scr, r, lane); return; } r -= I_SQ;
    if (r < I_MLQ) { tr_item(p->in[30], DM, 3072, (bf16_t*)(ws + WS_NAQ), 0, scr, r, lane); return; } r -= I_MLQ;
    if (r < I_SQ) { tr_item(p->in[31], DM, DM, (bf16_t*)(ws + WS_NAO), 0, scr, r, lane); return; } r -= I_SQ;
    { const int b = r / I_VC, rr = r % I_VC; tr_item(p->in[6] + (size_t)b * 512 * DM, 512, DM, (bf16_t*)(ws + WS_VCT) + (size_t)b * DM * 512, 0, scr, rr, lane); }
}
DI void conv_range(KP p, LAS unsigned char* lds, int wave, int lane, int lo, int hi, int rank, int nranks) {
    LAS float* scr = (LAS float*)(lds + wave * 16384);
    for (int it = lo + rank; it < hi; it += nranks) conv_item(p, scr, it, lane);
}

DI void prologue(KP p, LAS unsigned char* lds, int wave, int bid_) {
    const int lane = fresh_lane(), tid_ = wave * 64 + lane;
    unsigned char* ws = p->ws; const int G = gridDim.x, NGW = G * 8, gw = bid_ * 8 + wave; const int gt = bid_ * 512 + tid_, NT = G * 512;
    conv_range(p, lds, wave, lane, 0, 4224, gw, NGW); conv_range(p, lds, wave, lane, 33792, 33792 + 2560, gw, NGW); conv_range(p, lds, wave, lane, 33792 + 6656, 33792 + 7168, gw, NGW);
    { float* mods = (float*)(ws + WS_MODS);
      for (int it = gw; it < 4 * 16 * 36; it += NGW) { const int l = it / 576, r = it % 576, ks = r / 36, cb = r % 36, n0 = cb * 256 + 4 * lane;
          f32x4 a0 = {0.f, 0.f, 0.f, 0.f}, a1 = a0, a2 = a0;
          const float* w = p->in[9] + ((size_t)l * DM + ks * 64) * 9216 + n0;
#pragma unroll 8
          for (int k = 0; k < 64; ++k) { const int kk = ks * 64 + k; const f32x4 wv = __builtin_nontemporal_load((const f32x4*)(w + (size_t)k * 9216));
              const float s0 = fsilu(p->in[8][kk]), s1 = fsilu(p->in[7][kk]), s2 = fsilu(p->in[7][1024 + kk]); a0 += wv * s0; a1 += wv * s1; a2 += wv * s2; }
          if (ks == 0) { const f32x4 bv = *(const f32x4*)(p->in[10] + l * 9216 + n0); a0 += bv; a1 += bv; a2 += bv; }
          float* m0 = mods + (size_t)(l * 3) * 9216 + n0;
#pragma unroll
          for (int e = 0; e < 4; ++e) { __hip_atomic_fetch_add(m0 + e, a0[e], __ATOMIC_RELAXED, __HIP_MEMORY_SCOPE_AGENT); __hip_atomic_fetch_add(m0 + 9216 + e, a1[e], __ATOMIC_RELAXED, __HIP_MEMORY_SCOPE_AGENT);
              __hip_atomic_fetch_add(m0 + 2 * 9216 + e, a2[e], __ATOMIC_RELAXED, __HIP_MEMORY_SCOPE_AGENT); } } }
    { unsigned* t = (unsigned*)(ws + WS_DS2048);
      for (int i = gt; i < 4096 * 2048 / 2; i += NT) { const int r = i >> 10, s = (i & 1023) * 2, cs = r >> 11, sp = r & 2047; const int p0 = (s * sp) & 2047, p1 = ((s + 1) * sp) & 2047;
          const float a0 = p0 * (1.0f / 1024.0f), a1 = p1 * (1.0f / 1024.0f); t[i] = cs ? pk2(sinpif(a0), sinpif(a1)) : pk2(cospif(a0), cospif(a1)); }
      unsigned* t2 = (unsigned*)(ws + WS_DS256);
      for (int i = gt; i < 512 * 256 / 2; i += NT) { const int r = i >> 7, s = (i & 127) * 2, cs = r >> 8, sp = r & 255; const int p0 = (s * sp) & 255, p1 = ((s + 1) * sp) & 255;
          const float a0 = p0 * (1.0f / 128.0f), a1 = p1 * (1.0f / 128.0f); t2[i] = cs ? pk2(sinpif(a0), sinpif(a1)) : pk2(cospif(a0), cospif(a1)); }
      unsigned* t3 = (unsigned*)(ws + WS_DC);
      for (int i = gt; i < 256 * 512 / 2; i += NT) { const int cp = i >> 8, k = (i & 255) * 2, sn = k >> 8, c = k & 255; const int p0 = (c * cp) & 255, p1 = ((c + 1) * cp) & 255;
          const float a0 = p0 * (1.0f / 128.0f), a1 = p1 * (1.0f / 128.0f); t3[i] = sn ? pk2(-sinpif(a0), -sinpif(a1)) : pk2(cospif(a0), cospif(a1)); }
      unsigned* t4 = (unsigned*)(ws + WS_ABLK); const float* wsp = p->in[27];
      for (int i = gt; i < 4 * 256 * 256 / 2; i += NT) { const int g = i >> 15, r = (i >> 7) & 255, k = (i & 127) * 2; const bool on = (r >> 7) == (k >> 7);
          const float* s = wsp + ((size_t)g * 128 + (r & 127)) * 128 + (k & 127); t4[i] = on ? pk2(s[0], s[1]) : 0u; }
      unsigned* t5 = (unsigned*)(ws + WS_KC); const f32x2* ck = (const f32x2*)p->in[5];
      for (int i = gt; i < 2 * 512 * DM / 2; i += NT) { const f32x2 v = ck[i]; t5[i] = pk2(v.x, v.y); } }
}

DI void norm_row(KP p, int l, int idx, int row, int lane, f32x4 (&y)[4]) {
    const float* x = p->out + (size_t)row * DM; float ss = 0.f;
#pragma unroll
    for (int j = 0; j < 4; ++j) { y[j] = *(const f32x4*)(x + 4 * lane + 256 * j); ss += (y[j][0] * y[j][0] + y[j][1] * y[j][1]) + (y[j][2] * y[j][2] + y[j][3] * y[j][3]); }
    const float rstd = rsqrtf(wave_sum(ss, lane) * (1.0f / DM) + EPSN);
    const int cond = row < M_CTX ? 0 : 1 + ((row - M_CTX) >> 11);
    const float* md = (const float*)(p->ws + WS_MODS) + (size_t)(l * 3 + cond) * 9216 + (3 * idx) * DM; const float* g = p->in[11] + (size_t)(l * 3 + idx) * DM;
#pragma unroll
    for (int j = 0; j < 4; ++j) { const int c = 4 * lane + 256 * j; const f32x4 gv = *(const f32x4*)(g + c), sh = *(const f32x4*)(md + c), sc = *(const f32x4*)(md + DM + c);
        y[j] = (y[j] * rstd) * gv * (sc + 1.0f) + sh; }
}

DI void norm_phase(KP p, int l, int idx, int wave, int bid_) {
    const int lane = fresh_lane();
    const int G = gridDim.x, NGW = G * 8, gw = bid_ * 8 + wave; bf16_t* HB = (bf16_t*)(p->ws + WS_HB);
    const bool gates = (l == 0 && idx == 1), first = (l == 0 && idx == 0);
    const float* g = p->in[11] + (size_t)(l * 3 + idx) * DM;
    for (int base = gw * 6; base < M_TOK; base += NGW * 6) {
        int ccur = -1; f32x4 gs[4], shv[4];
#pragma unroll
        for (int j = 0; j < 4; ++j) { gs[j] = (f32x4){0.f, 0.f, 0.f, 0.f}; shv[j] = gs[j]; }
#pragma unroll
        for (int hh = 0; hh < 2; ++hh) {
            const int row0 = base + hh * 3;
            f32x4 y[3][4]; float ss[3];
#pragma unroll
            for (int q = 0; q < 3; ++q) { const int row = row0 + q; ss[q] = 0.f;
                if (row < M_TOK) { const float* x = first ? (row < M_CTX ? p->in[0] + (size_t)row * DM : p->in[1] + (size_t)(row - M_CTX) * DM) : p->out + (size_t)row * DM;
#pragma unroll
                    for (int j = 0; j < 4; ++j) y[q][j] = *(const f32x4*)(x + 8 * lane + 512 * (j >> 1) + 4 * (j & 1)); }
                else {
#pragma unroll
                    for (int j = 0; j < 4; ++j) y[q][j] = (f32x4){0.f, 0.f, 0.f, 0.f}; } }
#pragma unroll
            for (int q = 0; q < 3; ++q) {
#pragma unroll
                for (int j = 0; j < 4; ++j) ss[q] += (y[q][j][0] * y[q][j][0] + y[q][j][1] * y[q][j][1]) + (y[q][j][2] * y[q][j][2] + y[q][j][3] * y[q][j][3]); }
#pragma unroll
            for (int o = 1; o < 64; o <<= 1) {
#pragma unroll
                for (int q = 0; q < 3; ++q) ss[q] += shx(ss[q], o, lane); }
#pragma unroll
            for (int q = 0; q < 3; ++q) { const int row = row0 + q; if (row >= M_TOK) continue;
                const float rstd = rsqrtf(ss[q] * (1.0f / DM) + EPSN);
                const int cond = row < M_CTX ? 0 : 1 + ((row - M_CTX) >> 11);
                if (cond != ccur) { ccur = cond; const float* md = (const float*)(p->ws + WS_MODS) + (size_t)(l * 3 + cond) * 9216 + (3 * idx) * DM;
#pragma unroll
                    for (int j = 0; j < 4; ++j) { const int c = 8 * lane + 512 * (j >> 1) + 4 * (j & 1); gs[j] = *(const f32x4*)(g + c) * (*(const f32x4*)(md + DM + c) + 1.0f); shv[j] = *(const f32x4*)(md + c); } }
#pragma unroll
                for (int j = 0; j < 4; ++j) y[q][j] = (y[q][j] * rstd) * gs[j] + shv[j];
#pragma unroll
                for (int jj = 0; jj < 2; ++jj) { u32x4 w; w.x = pk2(y[q][2 * jj][0], y[q][2 * jj][1]); w.y = pk2(y[q][2 * jj][2], y[q][2 * jj][3]); w.z = pk2(y[q][2 * jj + 1][0], y[q][2 * jj + 1][1]); w.w = pk2(y[q][2 * jj + 1][2], y[q][2 * jj + 1][3]);
                    *(u32x4*)(HB + (size_t)row * DM + 8 * lane + 512 * jj) = w; }
                if (gates) {
                    float a[16];
#pragma unroll
                    for (int o = 0; o < 16; ++o) a[o] = 0.f;
                    const float* wif = p->in[17];
#pragma unroll
                    for (int j = 0; j < 4; ++j)
#pragma unroll
                        for (int e = 0; e < 4; ++e) { const int c = 8 * lane + 512 * (j >> 1) + 4 * (j & 1) + e; const float yv = y[q][j][e];
#pragma unroll
                            for (int d = 0; d < 2; ++d) { const f32x4 w0 = *(const f32x4*)(wif + ((size_t)d * DM + c) * 8), w1 = *(const f32x4*)(wif + ((size_t)d * DM + c) * 8 + 4);
#pragma unroll
                                for (int o = 0; o < 4; ++o) { a[d * 8 + o] += yv * w0[o]; a[d * 8 + 4 + o] += yv * w1[o]; } } }
                    float sel = 0.f;
#pragma unroll
                    for (int o = 0; o < 16; ++o) { const float t = wave_sum(a[o], lane); sel = (lane == o) ? t : sel; }
                    if (lane < 16) { float v = sel + p->in[18][lane]; if ((lane & 7) >= 4) v = logsigmoidf(v); ((float*)(p->ws + WS_IFG))[(size_t)row * 16 + lane] = v; }
                }
            }
        }
    }
}

DI void tile_T_write(LAS unsigned char* lds, bf16_t* dst, int tok0, int tid_) {
    __syncthreads();
    const int cp = tid_;
#pragma unroll
    for (int tg = 0; tg < 8; ++tg) { unsigned v[8];
#pragma unroll
        for (int i = 0; i < 8; ++i) v[i] = *(const LAS unsigned*)(lds + (tg * 8 + i) * 2048 + cp * 4);
        u32x4 lo, hi;
        lo.x = (v[0] & 0xffffu) | (v[1] << 16); lo.y = (v[2] & 0xffffu) | (v[3] << 16); lo.z = (v[4] & 0xffffu) | (v[5] << 16); lo.w = (v[6] & 0xffffu) | (v[7] << 16);
        hi.x = (v[0] >> 16) | (v[1] & 0xffff0000u); hi.y = (v[2] >> 16) | (v[3] & 0xffff0000u); hi.z = (v[4] >> 16) | (v[5] & 0xffff0000u); hi.w = (v[6] >> 16) | (v[7] & 0xffff0000u);
        *(u32x4*)(dst + (size_t)(2 * cp) * M_TOK + tok0 + tg * 8) = lo; *(u32x4*)(dst + (size_t)(2 * cp + 1) * M_TOK + tok0 + tg * 8) = hi; }
    __syncthreads();
}
DI void normT_phase(KP p, LAS unsigned char* lds, int l, int idx, int wave, int bid_) {
    const int lane = fresh_lane(), tid_ = wave * 64 + lane;
    bf16_t* HT = (bf16_t*)(p->ws + WS_SCR + SCR_HT); const float* g = p->in[11] + (size_t)(l * 3 + idx) * DM;
    for (int blk = bid_; blk < M_TOK / 64; blk += gridDim.x) {
        const int r00 = blk * 64; const int cond = r00 < M_CTX ? 0 : 1 + ((r00 - M_CTX) >> 11);
        const float* md = (const float*)(p->ws + WS_MODS) + (size_t)(l * 3 + cond) * 9216 + (3 * idx) * DM;
        f32x4 gs[4], shv[4];
#pragma unroll
        for (int j = 0; j < 4; ++j) { const int c = 4 * lane + 256 * j; gs[j] = *(const f32x4*)(g + c) * (*(const f32x4*)(md + DM + c) + 1.0f); shv[j] = *(const f32x4*)(md + c); }
        for (int i = 0; i < 8; ++i) { const int rt = wave * 8 + i; const float* x = p->out + (size_t)(r00 + rt) * DM; f32x4 y[4]; float ss = 0.f;
#pragma unroll
            for (int j = 0; j < 4; ++j) { y[j] = *(const f32x4*)(x + 4 * lane + 256 * j); ss += (y[j][0] * y[j][0] + y[j][1] * y[j][1]) + (y[j][2] * y[j][2] + y[j][3] * y[j][3]); }
            const float rstd = rsqrtf(wave_sum(ss, lane) * (1.0f / DM) + EPSN);
#pragma unroll
            for (int j = 0; j < 4; ++j) { const f32x4 v = (y[j] * rstd) * gs[j] + shv[j]; u32x2 w; w.x = pk2(v[0], v[1]); w.y = pk2(v[2], v[3]); *(LAS u32x2*)(lds + rt * 2048 + (4 * lane + 256 * j) * 2) = w; } }
        tile_T_write(lds, HT, blk * 64, tid_);
    }
}
DI void gtrans_phase(KP p, LAS unsigned char* lds, int wave, int bid_) {
    const int lane = fresh_lane(), tid_ = wave * 64 + lane;
    const bf16_t* V = (const bf16_t*)(p->ws + WS_SCR + SCR_V); bf16_t* VNT = (bf16_t*)(p->ws + WS_SCR + SCR_VNT);
    for (int blk = bid_; blk < M_TOK / 64; blk += gridDim.x) {
        for (int i = 0; i < 8; ++i) { const int rt = wave * 8 + i; const bf16_t* vr = V + (size_t)(blk * 64 + rt) * DM; u32x2 w[4]; float ss = 0.f;
#pragma unroll
            for (int j = 0; j < 4; ++j) { w[j] = *(const u32x2*)(vr + 4 * lane + 256 * j); const float a = bflo(w[j].x), b = bfhi(w[j].x), c = bflo(w[j].y), d = bfhi(w[j].y); ss += (a * a + b * b) + (c * c + d * d); }
            const float rstd = rsqrtf(wave_sum(ss, lane) * (1.0f / DM) + EPSN);
#pragma unroll
            for (int j = 0; j < 4; ++j) { u32x2 o; o.x = pk2(bflo(w[j].x) * rstd, bfhi(w[j].x) * rstd); o.y = pk2(bflo(w[j].y) * rstd, bfhi(w[j].y) * rstd); *(LAS u32x2*)(lds + rt * 2048 + (4 * lane + 256 * j) * 2) = o; } }
        tile_T_write(lds, VNT, blk * 64, tid_);
    }
}
DI void final_phase(KP p, int wave, int bid_) {
    const int lane = fresh_lane();
    const int NGW = gridDim.x * 8, gw = bid_ * 8 + wave; const float* g = p->in[12];
    f32x4 gvv[4];
#pragma unroll
    for (int j = 0; j < 4; ++j) gvv[j] = *(const f32x4*)(g + 4 * lane + 256 * j);
    for (int row0 = gw; row0 < M_TOK; row0 += 3 * NGW) {
        f32x4 y[3][4]; float ss[3];
#pragma unroll
        for (int q = 0; q < 3; ++q) { const int row = row0 + q * NGW; ss[q] = 0.f;
            if (row < M_TOK) { const float* x = p->out + (size_t)row * DM;
#pragma unroll
                for (int j = 0; j < 4; ++j) y[q][j] = *(const f32x4*)(x + 4 * lane + 256 * j); }
            else {
#pragma unroll
                for (int j = 0; j < 4; ++j) y[q][j] = (f32x4){0.f, 0.f, 0.f, 0.f}; } }
#pragma unroll
        for (int q = 0; q < 3; ++q) {
#pragma unroll
            for (int j = 0; j < 4; ++j) ss[q] += (y[q][j][0] * y[q][j][0] + y[q][j][1] * y[q][j][1]) + (y[q][j][2] * y[q][j][2] + y[q][j][3] * y[q][j][3]); }
#pragma unroll
        for (int o = 1; o < 64; o <<= 1) {
#pragma unroll
            for (int q = 0; q < 3; ++q) ss[q] += shx(ss[q], o, lane); }
#pragma unroll
        for (int q = 0; q < 3; ++q) { const int row = row0 + q * NGW; if (row >= M_TOK) continue; float* x = p->out + (size_t)row * DM;
            const float rstd = rsqrtf(ss[q] * (1.0f / DM) + EPSN);
#pragma unroll
            for (int j = 0; j < 4; ++j) *(f32x4*)(x + 4 * lane + 256 * j) = (y[q][j] * rstd) * gvv[j]; }
    }
}

DI void chunk_scan(const float* ifg, int tc, int dir, int h, int lane, float& i0, float& i1, float& b0, float& b1, float& blast) {
    const float* r0 = ifg + (size_t)(tc + 2 * lane) * 16 + dir * 8 + h; i0 = r0[0]; i1 = r0[16]; const float f0 = r0[4], f1 = r0[20];
    float inc = f0 + f1;
    if (dir == 0) {
#pragma unroll
        for (int o = 1; o < 64; o <<= 1) { const float t = bperm(lane - o, inc); if (lane >= o) inc += t; }
        float ex = bperm(lane - 1, inc); if (lane == 0) ex = 0.f; b0 = ex + f0; b1 = inc; blast = bperm(63, inc);
    } else {
#pragma unroll
        for (int o = 1; o < 64; o <<= 1) { const float t = bperm(lane + o, inc); if (lane + o < 64) inc += t; }
        float ex = bperm(lane + 1, inc); if (lane == 63) ex = 0.f; b1 = ex + f1; b0 = inc; blast = bperm(0, inc);
    }
}
DI int ml_sidx(bool lat, int b, int h, int dir, int ci) { return lat ? (((b * 4 + h) * 2 + dir) * 16 + ci) : (256 + ((b * 4 + h) * 2 + dir)); }

DI void ml1_job(KP p, LAS unsigned char* lds, int wave, int lane, int tid_, bool lat, int v) {
    unsigned char* ws = p->ws; const int fr = lane & 15, fq = lane >> 4;
    LAS float* wsc = (LAS float*)(lds + 69632 + wave * 2048); const unsigned lofT0 = (unsigned)(fr * M_TOK + 8 * fq) * 2u, lofS0 = (unsigned)(4 * fq * 256 + fr) * 2u;
    const float* ifg = (const float*)(ws + WS_IFG); const bf16_t* KT = (const bf16_t*)(ws + WS_SCR + SCR_KT); const bf16_t* VT = (const bf16_t*)(ws + WS_SCR + SCR_VT);
    float* mlst = (float*)(ws + WS_MLST);
    const int dvh = v & 1, dkh = (v >> 1) & 1, dir = (v >> 2) & 1, h = (v >> 3) & 3, b = v >> 5; const int dv0 = dvh * 128;
    const int tok0 = lat ? M_CTX + b * 2048 : b * 256, nch = lat ? 16 : 2, ncomp = lat ? 15 : 2; const int dk0 = dkh * 128 + wave * 16;
    f32x4 acc[8]; float nst; float mst;
    if (lat) { const int si = (b * 2 + dir) * 4 + h; const float* C0 = p->in[2] + (size_t)si * 65536; const float* n0 = p->in[3] + (size_t)si * 256; mst = p->in[4][si];
        int l3 = lane; asm volatile("" : "+v"(l3)); const int fr3 = l3 & 15, fq3 = l3 >> 4;
        nst = n0[dk0 + fr3];
#pragma unroll
        for (int dvb = 0; dvb < 8; ++dvb) acc[dvb] = *(const f32x4*)(C0 + (size_t)(dk0 + fr3) * 256 + dv0 + dvb * 16 + 4 * fq3);
    } else { mst = 0.f; nst = 0.f;
#pragma unroll
        for (int dvb = 0; dvb < 8; ++dvb) acc[dvb] = (f32x4){0.f, 0.f, 0.f, 0.f}; }
    u32x4 pre[4];
    { int tl = tid_; asm volatile("" : "+v"(tl)); const int oc = dir ? nch - 1 : 0; const unsigned char* src = (const unsigned char*)(VT + (size_t)(h * 256 + dv0) * M_TOK + tok0 + oc * 128);
#pragma unroll
      for (int i = 0; i < 4; ++i) { const int idx = i * 512 + tl, row = idx >> 4, c = idx & 15; pre[i] = *(const u32x4*)(src + (size_t)row * (M_TOK * 2) + c * 16); } }
    for (int ci = 0; ci <= ncomp; ++ci) {
        if (ci > 0 || lat) {
            if (lat || ci < nch) {
            unsigned lofS = lofS0; asm volatile("" : "+v"(lofS));
            const int sidx = ml_sidx(lat, b, h, dir, ci); bf16_t* sn = (bf16_t*)(ws + WS_SCR + SCR_SNAP) + (size_t)sidx * 65536; float* st = mlst + (size_t)sidx * MLST_STRIDE;
            gwp ps = (gwp)(sn + (size_t)dv0 * 256 + dk0) + lofS;
#pragma unroll
            for (int dvb = 0; dvb < 8; ++dvb) {
#pragma unroll
                for (int r = 0; r < 4; ++r) *(GAS bf16_t*)(ps + r * 512) = (bf16_t)(pk2(acc[dvb][r], 0.f) & 0xffffu);
                ps += 16 * 512; asm volatile("" : "+v"(ps)); }
            if (fq == 0 && dvh == 0) st[dk0 + fr] = nst;
            if (dvh == 0 && dkh == 0 && wave == 0 && lane == 0) st[256] = mst; }
        }
        if (ci == ncomp) break;
        const int oc = dir ? nch - 1 - ci : ci, tc = tok0 + oc * 128;
        __syncthreads();
        { int tl = tid_; asm volatile("" : "+v"(tl));
#pragma unroll
          for (int i = 0; i < 4; ++i) { const int idx = i * 512 + tl, row = idx >> 4, c = idx & 15; *(LAS u32x4*)(lds + row * 272 + c * 16) = pre[i]; } }
        __syncthreads();
        if (ci + 1 < ncomp) { int tl = tid_; asm volatile("" : "+v"(tl)); const int oc2 = dir ? nch - 2 - ci : ci + 1; const unsigned char* src = (const unsigned char*)(VT + (size_t)(h * 256 + dv0) * M_TOK + tok0 + oc2 * 128);
#pragma unroll
            for (int i = 0; i < 4; ++i) { const int idx = i * 512 + tl, row = idx >> 4, c = idx & 15; pre[i] = *(const u32x4*)(src + (size_t)row * (M_TOK * 2) + c * 16); } }
        unsigned lofT = lofT0; asm volatile("" : "+v"(lofT));
        float i0, i1, b0, b1, blast; chunk_scan(ifg, tc, dir, h, lane, i0, i1, b0, b1, blast);
        const float g0 = blast - b0 + i0, g1 = blast - b1 + i1; const float mloc = wave_max(fmaxf(g0, g1), lane); const float mnew = fmaxf(blast + mst, mloc);
        wsc[2 * lane] = __expf(g0 - mnew); wsc[2 * lane + 1] = __expf(g1 - mnew); const float decay = __expf(blast + mst - mnew);
#pragma unroll
        for (int dvb = 0; dvb < 8; ++dvb) acc[dvb] *= decay;
        bf16x8 Bf[4]; float nsum = 0.f;
#pragma unroll
        for (int ks = 0; ks < 4; ++ks) { const f32x4 w0 = *(const LAS f32x4*)(wsc + ks * 32 + 8 * fq), w1 = *(const LAS f32x4*)(wsc + ks * 32 + 8 * fq + 4);
            const u32x4 kv = __builtin_bit_cast(u32x4, ldf16(KT + (size_t)(h * 256 + dk0) * M_TOK + tc + ks * 32, lofT));
            const float e0 = bflo(kv.x) * w0[0], e1 = bfhi(kv.x) * w0[1], e2 = bflo(kv.y) * w0[2], e3 = bfhi(kv.y) * w0[3], e4 = bflo(kv.z) * w1[0], e5 = bfhi(kv.z) * w1[1], e6 = bflo(kv.w) * w1[2], e7 = bfhi(kv.w) * w1[3];
            nsum += ((e0 + e1) + (e2 + e3)) + ((e4 + e5) + (e6 + e7));
            u32x4 o; o.x = pk2(e0, e1); o.y = pk2(e2, e3); o.z = pk2(e4, e5); o.w = pk2(e6, e7); Bf[ks] = __builtin_bit_cast(bf16x8, o); }
        const LAS unsigned char* lv = lds + fr * 272 + fq * 16;
#pragma unroll
        for (int dvb = 0; dvb < 8; ++dvb) {
            if ((dvb & 3) == 0) __builtin_amdgcn_sched_barrier(0);
#pragma unroll
            for (int ks = 0; ks < 4; ++ks) { const bf16x8 A = *(const LAS bf16x8*)(lv + dvb * (16 * 272) + ks * 64); acc[dvb] = MFMA16(A, Bf[ks], acc[dvb]); } }
        __builtin_amdgcn_sched_barrier(0);
        { float s2 = nsum; s2 += shx(s2, 16, lane); s2 += shx(s2, 32, lane); nst = decay * nst + s2; }
        mst = mnew;
    }
    if (!lat) { const int si = (b * 2 + dir) * 4 + h; float* Co = p->out + O_C + (size_t)si * 65536; float* no = p->out + O_N + (size_t)si * 256;
        int l2 = lane; asm volatile("" : "+v"(l2)); const int fr2 = l2 & 15, fq2 = l2 >> 4;
#pragma unroll
        for (int dvb = 0; dvb < 8; ++dvb) *(f32x4*)(Co + (size_t)(dk0 + fr2) * 256 + dv0 + dvb * 16 + 4 * fq2) = acc[dvb];
        if (fq2 == 0 && dvh == 0) no[dk0 + fr2] = nst;
        if (dvh == 0 && dkh == 0 && wave == 0 && l2 == 0) p->out[O_M + si] = mst; }
}
DI void ml1_phase(KP p, LAS unsigned char* lds, int wave, int bid_) {
    const int lane = fresh_lane(), tid_ = wave * 64 + lane;
    const int G = gridDim.x;
    if (G >= 128) {
        if (bid_ < 64) ml1_job(p, lds, wave, lane, tid_, true, bid_);
        else for (int c = bid_ - 64; c < 1024; c += G - 64) ml1_job(p, lds, wave, lane, tid_, false, c);
    } else {
        for (int j = bid_; j < 1088; j += G) ml1_job(p, lds, wave, lane, tid_, j < 64, j < 64 ? j : j - 64);
    }
    __syncthreads();
}

constexpr int ML2_VT = 0, ML2_B = 69632, ML2_SC = 137216;
DI void ml2_stage512(LAS unsigned char* dst, const unsigned char* src, size_t stride, int tid_) {
    asm volatile("" : "+v"(tid_));
#pragma unroll
    for (int hh = 0; hh < 2; ++hh) { u32x4 v[4];
#pragma unroll
        for (int i = 0; i < 4; ++i) { const int idx = (hh * 4 + i) * 512 + tid_, row = idx >> 5, c = idx & 31; v[i] = *(const u32x4*)(src + (size_t)row * stride + c * 16); }
#pragma unroll
        for (int i = 0; i < 4; ++i) { const int idx = (hh * 4 + i) * 512 + tid_, row = idx >> 5, c = idx & 31; *(LAS u32x4*)(dst + row * 528 + c * 16) = v[i]; }
        __builtin_amdgcn_sched_barrier(0); }
}
DI void ml2_phase(KP p, LAS unsigned char* lds, int wave, int bid_) {
    const int lane_in = fresh_lane(), tid_ = wave * 64 + lane_in;
    unsigned char* ws = p->ws; const int lane0 = lane_in;
    const float* ifg = (const float*)(ws + WS_IFG); const bf16_t* Q = (const bf16_t*)(ws + WS_SCR + SCR_Q); const bf16_t* Kn = (const bf16_t*)(ws + WS_SCR + SCR_K);
    const bf16_t* VT = (const bf16_t*)(ws + WS_SCR + SCR_VT); const bf16_t* OG = (const bf16_t*)(ws + WS_SCR + SCR_OG); bf16_t* HB = (bf16_t*)(ws + WS_HB);
    const float* mlst = (const float*)(ws + WS_MLST);
    const bool deal = gridDim.x == 256; const int nmine = deal ? (bid_ < 128 ? 2 : 1) : 0;
    for (int ui_ = 0, uu = deal ? (bid_ < 128 ? 2 * bid_ : 128 + bid_) : bid_; deal ? (ui_ < nmine) : (uu < 384); ++ui_, uu += deal ? 1 : (int)gridDim.x) {
        int lane = lane0; asm volatile("" : "+v"(lane));
        const int fr = lane & 15, fq = lane >> 4; const unsigned lofK0 = (unsigned)(fr * DM + 8 * fq) * 2u;
        LAS float* bb = (LAS float*)(lds + ML2_SC + wave * 2048); LAS float* ib = bb + 128; LAS float* mt = bb + 256;
        const bool lat = uu >= 256; const int v = lat ? uu - 256 : uu; const int oc = lat ? (v & 15) : (v & 1), h = lat ? ((v >> 4) & 3) : ((v >> 1) & 3), b = lat ? (v >> 6) : (v >> 3);
        const int tok0 = lat ? M_CTX + b * 2048 : b * 256, nch = lat ? 16 : 2, tc = tok0 + oc * 128, tw = wave * 16;
        __syncthreads();
        { u32x4 vv[8]; const unsigned char* src = (const unsigned char*)(VT + (size_t)(h * 256) * M_TOK + tc); int tl = tid_; asm volatile("" : "+v"(tl));
#pragma unroll
          for (int i = 0; i < 8; ++i) { const int idx = i * 512 + tl, row = idx >> 4, c = idx & 15; vv[i] = *(const u32x4*)(src + (size_t)row * (M_TOK * 2) + c * 16); }
#pragma unroll
          for (int i = 0; i < 8; ++i) { const int idx = i * 512 + tl, row = idx >> 4, c = idx & 15; *(LAS u32x4*)(lds + ML2_VT + row * 272 + c * 16) = vv[i]; } }
        f32x4 hs[16];
#pragma unroll
        for (int d = 0; d < 16; ++d) hs[d] = (f32x4){0.f, 0.f, 0.f, 0.f};
        for (int dir = 0; dir < 2; ++dir) {
            unsigned lofK = lofK0; asm volatile("" : "+v"(lofK));
            int tcl = tc; asm volatile("" : "+s"(tcl));
            if (dir == 1) __syncthreads();
            ml2_stage512(lds + ML2_B, (const unsigned char*)(Kn + (size_t)tcl * DM + h * 256), DM * 2, tid_);
            const int ci = dir ? nch - 1 - oc : oc; const bool zero = (!lat && ci == 0); const int sidx = ml_sidx(lat, b, h, dir, ci);
            const float* st = mlst + (size_t)sidx * MLST_STRIDE; const float mprev = zero ? 0.f : st[256];
            { float i0, i1, b0, b1, blast; chunk_scan(ifg, tcl, dir, h, lane, i0, i1, b0, b1, blast);
              const float x0 = i0 - b0, x1 = i1 - b1; float inc = fmaxf(x0, x1), M0, M1;
              if (dir == 0) {
#pragma unroll
                  for (int o = 1; o < 64; o <<= 1) { const float t = bperm(lane - o, inc); if (lane >= o) inc = fmaxf(inc, t); }
                  float ex = bperm(lane - 1, inc); if (lane == 0) ex = -INFINITY; M0 = fmaxf(ex, x0); M1 = inc;
              } else {
#pragma unroll
                  for (int o = 1; o < 64; o <<= 1) { const float t = bperm(lane + o, inc); if (lane + o < 64) inc = fmaxf(inc, t); }
                  float ex = bperm(lane + 1, inc); if (lane == 63) ex = -INFINITY; M1 = fmaxf(ex, x1); M0 = inc;
              }
              bb[2 * lane] = b0; bb[2 * lane + 1] = b1; ib[2 * lane] = x0; ib[2 * lane + 1] = x1; mt[2 * lane] = b0 + fmaxf(mprev, M0); mt[2 * lane + 1] = b1 + fmaxf(mprev, M1); }
            bf16x8 qf[8];
#pragma unroll
            for (int ks = 0; ks < 8; ++ks) qf[ks] = ldf16(Q + (size_t)(tcl + tw) * DM + h * 256 + ks * 32, lofK);
            __syncthreads();
            const float bt = bb[tw + fr], mtt = mt[tw + fr];
            f32x4 S[8];
            const LAS unsigned char* lk = lds + ML2_B + fr * 528 + fq * 16;
#pragma unroll
            for (int sb = 0; sb < 8; ++sb) { S[sb] = (f32x4){0.f, 0.f, 0.f, 0.f}; __builtin_amdgcn_sched_barrier(0);
                if (dir ? (sb >= wave) : (sb <= wave)) {
#pragma unroll
                    for (int ks = 0; ks < 8; ++ks) { const bf16x8 A = *(const LAS bf16x8*)(lk + sb * (16 * 528) + ks * 64); S[sb] = MFMA16(A, qf[ks], S[sb]); } } }
            float dsum = 0.f; int t = tw + fr; asm volatile("" : "+v"(t)); const float e0 = bt - mtt; const int dsgn = dir ? -1 : 1;
#pragma unroll
            for (int sb = 0; sb < 8; ++sb) { const f32x4 iv = *(const LAS f32x4*)(ib + sb * 16 + 4 * fq);
#pragma unroll
                for (int r = 0; r < 4; ++r) { const int s2 = sb * 16 + 4 * fq + r; const int sg = dsgn * (s2 - t); const float pen = (float)max(sg, 0) * -1e30f; const float a = S[sb][r] * __expf(e0 + iv[r] + pen); S[sb][r] = a; dsum += a; } }
            bf16x8 aT[4];
#pragma unroll
            for (int kp = 0; kp < 4; ++kp) { u32x4 o; o.x = pk2(S[2 * kp][0], S[2 * kp][1]); o.y = pk2(S[2 * kp][2], S[2 * kp][3]); o.z = pk2(S[2 * kp + 1][0], S[2 * kp + 1][1]); o.w = pk2(S[2 * kp + 1][2], S[2 * kp + 1][3]); aT[kp] = __builtin_bit_cast(bf16x8, o); }
            dsum += shx(dsum, 16, lane); dsum += shx(dsum, 32, lane);
            const float winter = __expf(bt + mprev - mtt);
            float qn = 0.f;
            if (!zero) {
#pragma unroll
                for (int ks = 0; ks < 8; ++ks) { const f32x4 n0 = *(const f32x4*)(st + ks * 32 + 8 * fq), n1 = *(const f32x4*)(st + ks * 32 + 8 * fq + 4); const u32x4 qq = __builtin_bit_cast(u32x4, qf[ks]);
                    qn += (bflo(qq.x) * n0[0] + bfhi(qq.x) * n0[1]) + (bflo(qq.y) * n0[2] + bfhi(qq.y) * n0[3]) + (bflo(qq.z) * n1[0] + bfhi(qq.z) * n1[1]) + (bflo(qq.w) * n1[2] + bfhi(qq.w) * n1[3]); }
                qn += shx(qn, 16, lane); qn += shx(qn, 32, lane); }
            const float den = dsum + winter * qn; const float inv = 1.0f / fmaxf(fabsf(den), __expf(-mtt));
            const unsigned char* sn = ws + WS_SCR + SCR_SNAP + (size_t)sidx * 131072;
            if (!zero) {
#pragma unroll
                for (int ks = 0; ks < 8; ++ks) qf[ks] = ldf16(Q + (size_t)(tcl + tw) * DM + h * 256 + ks * 32, lofK);
            }
            const LAS unsigned char* lv = lds + ML2_VT + fr * 272 + fq * 8;
            const LAS unsigned char* lc = lds + ML2_B + fr * 528 + fq * 16;
#pragma unroll
            for (int half = 0; half < 2; ++half) {
                if (!zero) { __syncthreads(); ml2_stage512(lds + ML2_B, sn + half * 65536, 512, tid_); __syncthreads(); }
#pragma unroll
                for (int d8 = 0; d8 < 8; ++d8) { const int dvb = half * 8 + d8; __builtin_amdgcn_sched_barrier(0);
                    f32x4 num = {0.f, 0.f, 0.f, 0.f}, num2 = {0.f, 0.f, 0.f, 0.f};
#pragma unroll
                    for (int kp = 0; kp < 4; ++kp) { const u32x2 lo = *(const LAS u32x2*)(lv + dvb * (16 * 272) + kp * 64), hi = *(const LAS u32x2*)(lv + dvb * (16 * 272) + kp * 64 + 32); u32x4 a; a.x = lo.x; a.y = lo.y; a.z = hi.x; a.w = hi.y;
                        num = MFMA16(__builtin_bit_cast(bf16x8, a), aT[kp], num); }
                    if (!zero) {
#pragma unroll
                        for (int ks = 0; ks < 8; ++ks) { const bf16x8 A = *(const LAS bf16x8*)(lc + d8 * (16 * 528) + ks * 64); num2 = MFMA16(A, qf[ks], num2); } }
                    hs[dvb] += (num + num2 * winter) * inv; asm volatile("" : "+v"(hs[dvb])); }
            }
        }
        float ss = 0.f;
#pragma unroll
        for (int d = 0; d < 16; ++d) ss += (hs[d][0] * hs[d][0] + hs[d][1] * hs[d][1]) + (hs[d][2] * hs[d][2] + hs[d][3] * hs[d][3]);
        ss += shx(ss, 16, lane); ss += shx(ss, 32, lane);
        const float rstd = rsqrtf(ss * (1.0f / 256.0f) + EPSN); const size_t ro = (size_t)(tc + tw + fr) * DM + h * 256;
#pragma unroll
        for (int d = 0; d < 16; ++d) { if ((d & 3) == 0) __builtin_amdgcn_sched_barrier(0); const int c = d * 16 + 4 * fq; const f32x4 hg = *(const f32x4*)(p->in[20] + h * 256 + c); const u32x2 og = *(const u32x2*)(OG + ro + c);
            u32x2 w; w.x = pk2(hs[d][0] * rstd * hg[0] * bflo(og.x), hs[d][1] * rstd * hg[1] * bfhi(og.x)); w.y = pk2(hs[d][2] * rstd * hg[2] * bflo(og.y), hs[d][3] * rstd * hg[3] * bfhi(og.y));
            *(u32x2*)(HB + ro + c) = w; }
    }
    __syncthreads();
}

template <int MODE>
DI void attn_chunk(f32x4 (&O)[4], float& mrun, float& lrun, const bf16x8 (&qf)[2], int fr, int fq,
                   const LAS unsigned char* lk, const LAS unsigned char* lv, int vrow, int key0,
                   const bf16_t* kwin, const bf16_t* vwin, int h, const float* rpb, int yrel0, int col_start, int qc, int qstart) {
    const int lane = fq * 16 + fr;
    f32x4 S[8];
#pragma unroll
    for (int seg = 0; seg < 4; ++seg)
#pragma unroll
        for (int hb = 0; hb < 2; ++hb) { f32x4 sacc = {0.f, 0.f, 0.f, 0.f};
#pragma unroll
            for (int ks = 0; ks < 2; ++ks) { bf16x8 A;
                if (MODE == 0) A = *(const LAS bf16x8*)(lk + (key0 + seg * 32 + hb * 16 + fr) * 144 + ks * 64 + fq * 16);
                else A = *(const bf16x8*)(kwin + (size_t)(seg * 64 + hb * 16 + fr) * DM + h * 64 + ks * 32 + 8 * fq);
                sacc = MFMA16(A, qf[ks], sacc); }
            S[seg * 2 + hb] = sacc; }
    if (MODE == 1) {
#pragma unroll
        for (int seg = 0; seg < 4; ++seg) { const float* rb = rpb + (yrel0 + seg) * 31;
#pragma unroll
            for (int hb = 0; hb < 2; ++hb)
#pragma unroll
                for (int e = 0; e < 4; ++e) { const int kc = col_start + hb * 16 + 4 * fq + e; const bool valid = (kc >= qstart) && (kc < qstart + 16); const int dc = min(max(kc - qc + 15, 0), 30);
                    S[seg * 2 + hb][e] = valid ? S[seg * 2 + hb][e] + rb[dc] : -INFINITY; } } }
    float cm = -INFINITY;
#pragma unroll
    for (int i = 0; i < 8; ++i) cm = fmaxf(cm, fmaxf(fmaxf(S[i][0], S[i][1]), fmaxf(S[i][2], S[i][3])));
    cm = fmaxf(cm, shx(cm, 16, lane)); cm = fmaxf(cm, shx(cm, 32, lane));
    const float mnew = fmaxf(mrun, cm), alpha = __expf(mrun - mnew); mrun = mnew; float ps = 0.f;
#pragma unroll
    for (int i = 0; i < 8; ++i)
#pragma unroll
        for (int e = 0; e < 4; ++e) { const float pv = __expf(S[i][e] - mnew); S[i][e] = pv; ps += pv; }
    lrun = lrun * alpha + ps;
#pragma unroll
    for (int d = 0; d < 4; ++d) O[d] *= alpha;
#pragma unroll
    for (int seg = 0; seg < 4; ++seg) {
        u32x4 o; o.x = pk2(S[2 * seg][0], S[2 * seg][1]); o.y = pk2(S[2 * seg][2], S[2 * seg][3]); o.z = pk2(S[2 * seg + 1][0], S[2 * seg + 1][1]); o.w = pk2(S[2 * seg + 1][2], S[2 * seg + 1][3]);
        const bf16x8 pT = __builtin_bit_cast(bf16x8, o);
#pragma unroll
        for (int d = 0; d < 4; ++d) { u32x2 lo, hi;
            if (MODE == 0) { const LAS unsigned char* a = lv + (d * 16 + fr) * vrow + (key0 + seg * 32) * 2 + fq * 8; lo = *(const LAS u32x2*)a; hi = *(const LAS u32x2*)(a + 32); }
            else { const bf16_t* a = vwin + (size_t)(h * 64 + d * 16 + fr) * M_TOK + seg * 64 + 4 * fq; lo = *(const u32x2*)a; hi = *(const u32x2*)(a + 16); }
            u32x4 av; av.x = lo.x; av.y = lo.y; av.z = hi.x; av.w = hi.y;
            O[d] = MFMA16(__builtin_bit_cast(bf16x8, av), pT, O[d]); } }
}
DI void attn_store(bf16_t* HB, f32x4 (&O)[4], float lrun, int qtok, int h, int fr, int fq) {
    const int lane = fq * 16 + fr;
    lrun += shx(lrun, 16, lane); lrun += shx(lrun, 32, lane); const float inv = 1.0f / lrun;
#pragma unroll
    for (int d = 0; d < 4; ++d) { u32x2 w; w.x = pk2(O[d][0] * inv, O[d][1] * inv); w.y = pk2(O[d][2] * inv, O[d][3] * inv); *(u32x2*)(HB + (size_t)(qtok + fr) * DM + h * 64 + d * 16 + 4 * fq) = w; }
}
constexpr int ATT_LK = 0, ATT_LV = 73728;
DI void attn_phase(KP p, LAS unsigned char* lds, int wave, int bid_) {
    const int lane = fresh_lane(), tid_ = wave * 64 + lane;
    unsigned char* ws = p->ws; const int G = gridDim.x; const int fr = lane & 15, fq = lane >> 4;
    const bf16_t* Q = (const bf16_t*)(ws + WS_SCR + SCR_Q); const bf16_t* Kn = (const bf16_t*)(ws + WS_SCR + SCR_K); const bf16_t* VT = (const bf16_t*)(ws + WS_SCR + SCR_VT);
    const bf16_t* KC = (const bf16_t*)(ws + WS_KC); const bf16_t* VCT = (const bf16_t*)(ws + WS_VCT); bf16_t* HB = (bf16_t*)(ws + WS_HB);
    for (int job = bid_; job < 256; job += G) {
        const int bh = job & 31, sl = job >> 5, b = bh >> 4, h = bh & 15;
        __syncthreads();
        { int tl = tid_; asm volatile("" : "+v"(tl));
#pragma unroll
          for (int hh = 0; hh < 2; ++hh) { u32x4 v[4];
#pragma unroll
              for (int i = 0; i < 4; ++i) { const int idx = (hh * 4 + i) * 512 + tl, row = idx >> 3, c = idx & 7; v[i] = *(const u32x4*)((const unsigned char*)KC + (size_t)(b * 512 + row) * 2048 + h * 128 + c * 16); }
#pragma unroll
              for (int i = 0; i < 4; ++i) { const int idx = (hh * 4 + i) * 512 + tl, row = idx >> 3, c = idx & 7; *(LAS u32x4*)(lds + ATT_LK + row * 144 + c * 16) = v[i]; } }
#pragma unroll
          for (int hh = 0; hh < 2; ++hh) { u32x4 v[4];
#pragma unroll
              for (int i = 0; i < 4; ++i) { const int idx = (hh * 4 + i) * 512 + tl, row = idx >> 6, c = idx & 63; v[i] = *(const u32x4*)((const unsigned char*)VCT + (size_t)(b * DM + h * 64 + row) * 1024 + c * 16); }
#pragma unroll
              for (int i = 0; i < 4; ++i) { const int idx = (hh * 4 + i) * 512 + tl, row = idx >> 6, c = idx & 63; *(LAS u32x4*)(lds + ATT_LV + row * 1040 + c * 16) = v[i]; } } }
        __syncthreads();
        for (int rp2 = 0; rp2 < 2; ++rp2) {
            const int r = (sl * 2 + rp2) * 2 + (wave >> 2), cb = wave & 3; const int qtok = M_CTX + b * 2048 + r * 64 + cb * 16;
            const int row_start = min(max(r - 4, 0), 24), col_start = min(max(cb * 16 - 8, 0), 32);
            bf16x8 qf[2];
#pragma unroll
            for (int ks = 0; ks < 2; ++ks) qf[ks] = *(const bf16x8*)(Q + (size_t)(qtok + fr) * DM + h * 64 + ks * 32 + 8 * fq);
            f32x4 O[4];
#pragma unroll
            for (int d = 0; d < 4; ++d) O[d] = (f32x4){0.f, 0.f, 0.f, 0.f};
            float mrun = -INFINITY, lrun = 0.f; const int qc = cb * 16 + fr, qstart = min(max(qc - 8, 0), 48);
            const float* rpb = p->in[32] + (size_t)h * 15 * 31;
            for (int ch = 0; ch < 2; ++ch) { const int y0 = row_start + ch * 4; const size_t t0 = (size_t)M_CTX + b * 2048 + y0 * 64 + col_start;
                attn_chunk<1>(O, mrun, lrun, qf, fr, fq, lds, lds, 0, 0, Kn + t0 * DM, VT + t0, h, rpb, y0 - r + 7, col_start, qc, qstart); }
            for (int ch = 0; ch < 4; ++ch) attn_chunk<0>(O, mrun, lrun, qf, fr, fq, lds + ATT_LK, lds + ATT_LV, 1040, ch * 128, nullptr, nullptr, h, nullptr, 0, 0, 0, 0);
            attn_store(HB, O, lrun, qtok, h, fr, fq);
        }
    }
    for (int job = bid_; job < 512; job += G) {
        const int b = job >> 4, h = job & 15;
        __syncthreads();
        { int tl = tid_; asm volatile("" : "+v"(tl)); u32x4 v[4];
#pragma unroll
          for (int i = 0; i < 4; ++i) { const int idx = i * 512 + tl, row = idx >> 3, c = idx & 7; v[i] = *(const u32x4*)((const unsigned char*)Kn + (size_t)(b * 256 + row) * 2048 + h * 128 + c * 16); }
#pragma unroll
          for (int i = 0; i < 4; ++i) { const int idx = i * 512 + tl, row = idx >> 3, c = idx & 7; *(LAS u32x4*)(lds + ATT_LK + row * 144 + c * 16) = v[i]; }
#pragma unroll
          for (int i = 0; i < 4; ++i) { const int idx = i * 512 + tl, row = idx >> 5, c = idx & 31; v[i] = *(const u32x4*)((const unsigned char*)VT + ((size_t)(h * 64 + row) * M_TOK + b * 256) * 2 + c * 16); }
#pragma unroll
          for (int i = 0; i < 4; ++i) { const int idx = i * 512 + tl, row = idx >> 5, c = idx & 31; *(LAS u32x4*)(lds + ATT_LV + row * 528 + c * 16) = v[i]; } }
        __syncthreads();
        for (int q2 = 0; q2 < 2; ++q2) {
            const int qtok = b * 256 + (wave * 2 + q2) * 16;
            bf16x8 qf[2];
#pragma unroll
            for (int ks = 0; ks < 2; ++ks) qf[ks] = *(const bf16x8*)(Q + (size_t)(qtok + fr) * DM + h * 64 + ks * 32 + 8 * fq);
            f32x4 O[4];
#pragma unroll
            for (int d = 0; d < 4; ++d) O[d] = (f32x4){0.f, 0.f, 0.f, 0.f};
            float mrun = -INFINITY, lrun = 0.f;
            for (int ch = 0; ch < 2; ++ch) attn_chunk<0>(O, mrun, lrun, qf, fr, fq, lds + ATT_LK, lds + ATT_LV, 528, ch * 128, nullptr, nullptr, h, nullptr, 0, 0, 0, 0);
            attn_store(HB, O, lrun, qtok, h, fr, fq);
        }
    }
    __syncthreads();
}

#define XB_TMO      128
#define XB_XCNT(j)  (256  + 64 * (j))
#define XB_XSUB(j)  (1280 + 64 * (j))
#define XB_XGEN(j)  (2304 + 64 * (j))
#define XB_TOP      3328
#define XB_TOPGEN   3392
#define XCD_BAR_WORDS 3456
#define XB_SPIN_CAP (1u << 18)
DI unsigned xb_ld(unsigned* p)              { return __hip_atomic_load(p, __ATOMIC_RELAXED, __HIP_MEMORY_SCOPE_AGENT); }
DI unsigned xb_add(unsigned* p, unsigned v) { return __hip_atomic_fetch_add(p, v, __ATOMIC_RELAXED, __HIP_MEMORY_SCOPE_AGENT); }
DI unsigned xb_xcc_id() { return (unsigned)__builtin_amdgcn_s_getreg((3 << 11) | 20) & 0xFu; }
#define XB_SPIN(cond, bar) do { unsigned _sp = 0; while (cond) { __builtin_amdgcn_s_sleep(1); \
    if ((++_sp & 255u) == 0u) { if (xb_ld(&(bar)[XB_TMO])) break; if (_sp > XB_SPIN_CAP) { atomicAdd(&(bar)[XB_TMO], 1u); break; } } } } while (0)
DI void xcd_barrier_post(unsigned* bar, int tid) { if (tid == 0) (void)xb_add(&bar[XB_XCNT(xb_xcc_id())], 1u); }
DI void xcd_barrier_complete(unsigned* bar, unsigned x, unsigned& nloc, unsigned& nx) {
    const unsigned G = gridDim.x * gridDim.y * gridDim.z;
    unsigned sum, cnt, mine, sp = 0u;
    for (;;) {
        sum = 0u; cnt = 0u; mine = 0u;
#pragma unroll
        for (unsigned j = 0; j < 16; ++j) { const unsigned c = xb_ld(&bar[XB_XCNT(j)]); sum += c; cnt += (c > 0u) ? 1u : 0u; mine = (j == x) ? c : mine; }
        if (sum == G) break;
        __builtin_amdgcn_s_sleep(1);
        if ((++sp & 255u) == 0u) { if (xb_ld(&bar[XB_TMO])) break; if (sp > XB_SPIN_CAP) { atomicAdd(&bar[XB_TMO], 1u); break; } }
    }
    nloc = mine > 0u ? mine : 1u; nx = cnt > 0u ? cnt : 1u;
}
DI void xcd_barrier(unsigned* bar, volatile LAS unsigned* st, int tid) {
    asm volatile("s_waitcnt vmcnt(0)" ::: "memory");
    __syncthreads();
    if (tid == 0) {
        const unsigned x = xb_xcc_id();
        __builtin_amdgcn_s_waitcnt(0);
        unsigned nloc = st[0], nx = st[1];
        if (nloc == 0u) { xcd_barrier_complete(bar, x, nloc, nx); st[0] = nloc; st[1] = nx; }
        const unsigned old = xb_add(&bar[XB_XSUB(x)], 1u);
        const unsigned gen = old / nloc;
        if (old + 1u == (gen + 1u) * nloc) {
            __builtin_amdgcn_fence(__ATOMIC_RELEASE, "agent");
            asm volatile("s_waitcnt vmcnt(0)" ::: "memory");
            const unsigned og = xb_add(&bar[XB_TOP], 1u);
            const unsigned tg = og / nx;
            if (og + 1u == (tg + 1u) * nx) xb_add(&bar[XB_TOPGEN], 1u);
            else XB_SPIN(xb_ld(&bar[XB_TOPGEN]) == tg, bar);
            __builtin_amdgcn_fence(__ATOMIC_ACQUIRE, "agent");
            xb_add(&bar[XB_XGEN(x)], 1u);
            asm volatile("s_waitcnt vmcnt(0)" ::: "memory");
        } else {
            XB_SPIN(xb_ld(&bar[XB_XGEN(x)]) == gen, bar);
            __builtin_amdgcn_fence(__ATOMIC_ACQUIRE, "agent");
            asm volatile("s_waitcnt vmcnt(0)" ::: "memory");
        }
    }
    __syncthreads();
}

__global__ void __launch_bounds__(512, 2) fwd_megakernel(Params p_arg) {
    extern __shared__ __attribute__((aligned(16))) unsigned char lds_raw[];
    cg::grid_group grid = cg::this_grid();
    LAS unsigned char* lds = (LAS unsigned char*)lds_raw;
    const int wave0 = __builtin_amdgcn_readfirstlane(threadIdx.x >> 6); (void)p_arg;
    if (threadIdx.x < 4) ((LAS unsigned*)(lds + LDS_BARW))[threadIdx.x] = 0u;
    __syncthreads();
    xcd_barrier_post((unsigned*)p_arg.ws, (int)threadIdx.x);
    const int nsteps = NSTEPS < NSTEPS_RUN ? NSTEPS : NSTEPS_RUN;
    for (int st = 0; st < nsteps; ++st) {
        const int op = __builtin_amdgcn_readfirstlane(PROG[st][0]), arg = __builtin_amdgcn_readfirstlane(PROG[st][1]), sync = __builtin_amdgcn_readfirstlane(PROG[st][2]);
        int bid_ = blockIdx.x, wave = wave0; asm volatile("" : "+s"(bid_), "+s"(wave));
        KP p = (KP)__builtin_amdgcn_kernarg_segment_ptr(); asm volatile("" : "+s"(p));
        unsigned char* ws = p->ws;
        bool isgemm = false; pg8::GD g;
        g.sAz = 0; g.sBz = 0; g.sApn = 0; g.nZ = 1; g.perm = 1; g.G = gridDim.x; g.c = bid_; g.ws = ws; g.out = p->out; g.p0 = nullptr; g.p1 = nullptr; g.p2 = nullptr; g.p3 = nullptr; g.f0 = 1.f; g.i0 = 0; g.i1 = 0;
        g.A = (const char*)(ws + WS_HB); g.B = nullptr; g.lda = DM; g.ldb = DM; g.K = DM; g.nM = 48; g.nN = 4; g.mode = pg8::E_RES;
        const float* mods = (const float*)(ws + WS_MODS);
        switch (op) {

#ifndef SKIP_PRO
        case OP_PRO: prologue(p, lds, wave, bid_); break;
#endif


#ifndef SKIP_NORM
        case OP_NORM: norm_phase(p, arg >> 2, arg & 3, wave, bid_); break;
#endif


#ifndef SKIP_NORMT
        case OP_NORMT: normT_phase(p, lds, arg >> 2, arg & 3, wave, bid_); break;
#endif

        case OP_FFNUP: isgemm = true; g.B = (const char*)(ws + WS_W + (size_t)arg * FFN_BYTES); g.nN = 22; g.perm = 0; g.mode = pg8::E_FFNUP; break;
        case OP_FFNDN: isgemm = true; g.A = (const char*)(ws + WS_SCR); g.lda = LDG; g.B = (const char*)(ws + WS_W + (size_t)arg * FFN_BYTES + W13_BYTES); g.ldb = LDG; g.K = DFF; g.perm = 0;
            g.p0 = mods + (size_t)((arg >> 1) * 3) * 9216 + ((arg & 1) ? 8 : 2) * DM; g.f0 = 0.5f; if (arg == 0) { g.p2 = p->in[0]; g.p3 = p->in[1] - (size_t)M_CTX * DM; } break;
        case OP_MLQKV: isgemm = true; g.B = (const char*)(ws + WS_MLQ); g.nN = 16; g.mode = pg8::E_MLQKV; break;
        case OP_NAQKV: isgemm = true; g.B = (const char*)(ws + WS_NAQ); g.nN = 12; g.mode = pg8::E_NAQKV; break;
        case OP_MIXOUT: isgemm = true; g.perm = 0; g.p0 = mods + (size_t)(arg * 3) * 9216 + 5 * DM;
            g.B = (const char*)(ws + (arg == 0 ? WS_MLO : arg == 1 ? WS_FNO : arg == 2 ? WS_GMO : WS_NAO)); if (arg == 1) g.p1 = p->in[23]; break;
        case OP_F1L: isgemm = true; g.A = (const char*)(ws + WS_DS2048); g.lda = 2048; g.B = (const char*)(ws + WS_SCR + SCR_HT) + (size_t)M_CTX * 2; g.ldb = M_TOK; g.K = 2048; g.nM = 16; g.nN = 4; g.nZ = 2; g.sBz = 2048 * 2;
            g.mode = pg8::E_F1; g.i0 = 2048; g.i1 = M_CTX; g.G = gridDim.x / 2; g.c = bid_ < g.G ? bid_ : (1 << 28); break;
        case OP_F1C: isgemm = true; g.A = (const char*)(ws + WS_DS256); g.lda = 256; g.B = (const char*)(ws + WS_SCR + SCR_HT); g.ldb = M_TOK; g.K = 256; g.nM = 2; g.nN = 4; g.nZ = 32; g.sBz = 256 * 2;
            g.mode = pg8::E_F1; g.i0 = 256; g.i1 = 0; { const int G1 = gridDim.x / 2; g.G = gridDim.x - G1; g.c = bid_ >= G1 ? bid_ - G1 : (1 << 28); } break;
        case OP_F2: isgemm = true; g.A = (const char*)(ws + WS_SCR + SCR_Y); g.lda = 512; g.B = (const char*)(ws + WS_DC); g.ldb = 512; g.K = 512; g.nM = 192; g.nN = 1; g.mode = pg8::E_F2; break;
        case OP_GIN: isgemm = true; g.B = (const char*)(ws + WS_GMI); g.nN = 8; g.mode = pg8::E_GIN; g.p0 = p->in[25]; break;

#ifndef SKIP_GTR
        case OP_GTR: gtrans_phase(p, lds, wave, bid_); break;
#endif

        case OP_GSP: isgemm = true; g.A = (const char*)(ws + WS_ABLK); g.lda = 256; g.sApn = 256 * 256 * 2; g.B = (const char*)(ws + WS_SCR + SCR_VNT); g.ldb = M_TOK; g.K = 256; g.nM = 1; g.nN = 4; g.nZ = 48; g.sBz = 256 * 2;
            g.mode = pg8::E_SP; g.p0 = p->in[26]; g.p1 = p->in[28]; break;

#ifndef SKIP_ML1
        case OP_ML1: ml1_phase(p, lds, wave, bid_); break;
#endif


#ifndef SKIP_ML2
        case OP_ML2: ml2_phase(p, lds, wave, bid_); break;
#endif


#ifndef SKIP_ATT
        case OP_NAATT: attn_phase(p, lds, wave, bid_); break;
#endif


#ifndef SKIP_FIN
        case OP_FINAL: final_phase(p, wave, bid_); break;
#endif

        default: break;
        }

#ifndef SKIP_GEMM
        if (isgemm) pg8::gemm_phase(lds, g, wave);
#endif
#ifndef SKIP_BG
        if (isgemm) { const int lo1 = __builtin_amdgcn_readfirstlane(BGTAB[st][0]), hi1 = __builtin_amdgcn_readfirstlane(BGTAB[st][1]);
            if (hi1 > lo1) { const int nwg = g.nZ * g.nM * g.nN, Gg = gridDim.x, rounds = (nwg + Gg - 1) / Gg, first_idle = nwg - (rounds - 1) * Gg, nidle = Gg - first_idle;
                if (bid_ >= first_idle && nidle > 0) { const int lane = fresh_lane(); const int lo2 = __builtin_amdgcn_readfirstlane(BGTAB[st][2]), hi2 = __builtin_amdgcn_readfirstlane(BGTAB[st][3]);
                    const int rank = (bid_ - first_idle) * 8 + wave, nr = nidle * 8;
                    conv_range(p, lds, wave, lane, lo1, hi1, rank, nr); conv_range(p, lds, wave, lane, lo2, hi2, rank, nr); } } }
#endif

        if (sync) { if (p_arg.ws == nullptr) grid.sync();
            { int z2_ = 0; asm volatile("" : "+v"(z2_)); const int t0_ = wave0 * 64 + (int)__builtin_amdgcn_mbcnt_hi(~0u, __builtin_amdgcn_mbcnt_lo(~0u, z2_)); xcd_barrier((unsigned*)p_arg.ws, (volatile LAS unsigned*)(lds + LDS_BARW), t0_); } }
    }
}

extern "C" void kernel_launch(void* const* d_in, const int* in_sizes, int n_in, void* d_out, int out_size, void* d_ws, size_t ws_size, hipStream_t stream) {
    static int grid = 0;
    if (grid == 0) {
        if (n_in != 33 || ws_size < WS_END) { fprintf(stderr, "kernel_launch: unexpected n_in %d / ws_size %zu (need %zu)\n", n_in, ws_size, (size_t)WS_END); grid = -1; return; }
        int dev = 0, cus = 0, per_cu = 0;
        hipGetDevice(&dev); hipDeviceGetAttribute(&cus, hipDeviceAttributeMultiprocessorCount, dev);
        hipFuncSetAttribute((const void*)fwd_megakernel, hipFuncAttributeMaxDynamicSharedMemorySize, LDS_BYTES);
        hipOccupancyMaxActiveBlocksPerMultiprocessor(&per_cu, (const void*)fwd_megakernel, 512, LDS_BYTES);
        if (per_cu < 1) { fprintf(stderr, "kernel_launch: occupancy query says %d blocks per CU\n", per_cu); grid = -1; return; }
        grid = cus;
        fprintf(stderr, "kernel_launch: grid %d (per_cu %d), ws %zu\n", grid, per_cu, ws_size);
    }
    if (grid < 0) return;
    hipMemsetAsync(d_ws, 0, 2 * MiB, stream);
    Params p{};
    for (int i = 0; i < 33; ++i) p.in[i] = (const float*)d_in[i];
    p.out = (float*)d_out; p.ws = (unsigned char*)d_ws;
    void* args[] = {&p};
    hipError_t e = hipLaunchCooperativeKernel((const void*)fwd_megakernel, dim3(grid), dim3(512), args, LDS_BYTES, stream);
    if (e != hipSuccess) fprintf(stderr, "cooperative launch failed: %s (grid %d)\n", hipGetErrorString(e), grid);
}
```
